# Optimizing an MI355X kernel written in HIP

```python
import math
import jax, jax.numpy as jnp
from jax import lax
import numpy as np

D_MODEL = 1024
BATCH = 4
SEQ = 4096
DEPTH = 4

SB_HEADS = 4
SB_DIM = 64
DIFF_HEADS = 4
DIFF_QK_DIM = 64
DIFF_V_DIM = 2 * DIFF_QK_DIM
MLA_HEADS = 4
MLA_NOPE = 64
MLA_ROPE = 32
MLA_V = 64
MLA_Q_RANK = 256
MLA_KV_RANK = 128
MIX_WIDTH = SB_HEADS * SB_DIM + DIFF_HEADS * DIFF_V_DIM + MLA_HEADS * MLA_V
W_IN_SPLITS = (
    SB_HEADS * SB_DIM,
    SB_HEADS * SB_DIM,
    SB_HEADS * SB_DIM,
    DIFF_HEADS * 2 * DIFF_QK_DIM,
    DIFF_HEADS * 2 * DIFF_QK_DIM,
    DIFF_HEADS * DIFF_V_DIM,
    MLA_Q_RANK,
    MLA_KV_RANK,
    MLA_ROPE,
)
W_IN_COLS = sum(W_IN_SPLITS)
D_FF = 2816
PLE_DIM = 256
ROPE_THETA = 500000.0
PARTIAL_ROT = DIFF_QK_DIM // 4
Q_BLOCK = 128
EPS = 1e-6

kernel_name = 'hybrid_sb_diff_mla_macaron_trunk'


def rms_norm(x, gain):
    xf = x.astype(jnp.float32)
    y = xf * lax.rsqrt(jnp.mean(xf * xf, axis=-1, keepdims=True) + EPS)
    return (y * gain.astype(jnp.float32)).astype(x.dtype)


def rope_tables(positions, rot_dim):
    inv_freq = 1.0 / (ROPE_THETA ** (jnp.arange(0, rot_dim, 2, dtype=jnp.float32) / rot_dim))
    ang = positions.astype(jnp.float32)[..., None] * inv_freq
    return jnp.cos(ang), jnp.sin(ang)


def apply_rope(x, cos, sin):
    half = cos.shape[-1]
    x1 = x[..., :half].astype(jnp.float32)
    x2 = x[..., half:2 * half].astype(jnp.float32)
    rot = jnp.concatenate([x1 * cos - x2 * sin, x2 * cos + x1 * sin], axis=-1).astype(x.dtype)
    return jnp.concatenate([rot, x[..., 2 * half:]], axis=-1)


def swiglu(u, w_gu, w_down):
    g, v = jnp.split(u @ w_gu, 2, axis=-1)
    return (jax.nn.silu(g) * v) @ w_down


def to_blocks(t):
    b, s = t.shape[:2]
    return jnp.swapaxes(t.reshape((b, s // Q_BLOCK, Q_BLOCK) + t.shape[2:]), 0, 1)


def from_blocks(t):
    nb, b, qb = t.shape[:3]
    return jnp.swapaxes(t, 0, 1).reshape((b, nb * qb) + t.shape[3:])


def block_sweep(fn, q):
    nb = q.shape[1] // Q_BLOCK
    starts = jnp.arange(nb, dtype=jnp.int32) * Q_BLOCK
    return from_blocks(lax.map(fn, (to_blocks(q), starts)))


def causal_mask(start, seq, strict):
    qpos = start + jnp.arange(Q_BLOCK, dtype=jnp.int32)
    kpos = jnp.arange(seq, dtype=jnp.int32)
    if strict:
        return kpos[None, :] < qpos[:, None]
    return kpos[None, :] <= qpos[:, None]


def stick_breaking_attention(q, k, v):
    scale = q.shape[-1] ** -0.5

    def blk(args):
        qb, start = args
        z = jnp.einsum('bqhd,bkhd->bhqk', qb, k).astype(jnp.float32) * scale
        mask = causal_mask(start, k.shape[1], True)
        log_beta = jax.nn.log_sigmoid(z)
        log_keep = jnp.where(mask, jax.nn.log_sigmoid(-z), 0.0)
        log_between = lax.cumsum(log_keep, axis=3, reverse=True) - log_keep
        a = jnp.where(mask, jnp.exp(log_beta + log_between), 0.0)
        return jnp.einsum('bhqk,bkhd->bqhd', a.astype(v.dtype), v)

    return block_sweep(blk, q)


def differential_attention(q, k, v, lam):
    scale = q.shape[-1] ** -0.5

    def blk(args):
        qb, start = args
        s = jnp.einsum('bqhcd,bkhcd->bchqk', qb, k).astype(jnp.float32) * scale
        mask = causal_mask(start, k.shape[1], False)
        pr = jax.nn.softmax(jnp.where(mask, s, -jnp.inf), axis=-1)
        attn = pr[:, 0] - lam * pr[:, 1]
        return jnp.einsum('bhqk,bkhe->bqhe', attn.astype(v.dtype), v)

    return block_sweep(blk, q)


def causal_softmax_attention(q, k, v):
    scale = q.shape[-1] ** -0.5

    def blk(args):
        qb, start = args
        s = jnp.einsum('bqhd,bkhd->bhqk', qb, k).astype(jnp.float32) * scale
        mask = causal_mask(start, k.shape[1], False)
        pr = jax.nn.softmax(jnp.where(mask, s, -jnp.inf), axis=-1)
        return jnp.einsum('bhqk,bkhd->bqhd', pr.astype(v.dtype), v)

    return block_sweep(blk, q)


def token_mixing(u, rope_diff, rope_mla, layer, w_in, mla_q_norm, mla_w_uq, mla_kv_norm,
                 mla_w_ukv, lq1, lk1, lq2, lk2, diff_subln, w_out):
    b, s, _ = u.shape
    offsets = list(np.cumsum(W_IN_SPLITS)[:-1])
    (sb_q, sb_k, sb_v, df_q, df_k, df_v, c_q, c_kv, k_pe) = jnp.split(u @ w_in, offsets, axis=-1)

    shp = (b, s, SB_HEADS, SB_DIM)
    out_a = stick_breaking_attention(sb_q.reshape(shp), sb_k.reshape(shp), sb_v.reshape(shp))

    cos_d, sin_d = rope_diff
    qk_shp = (b, s, DIFF_HEADS, 2, DIFF_QK_DIM)
    dq = apply_rope(df_q.reshape(qk_shp), cos_d, sin_d)
    dk = apply_rope(df_k.reshape(qk_shp), cos_d, sin_d)
    dv = df_v.reshape(b, s, DIFF_HEADS, DIFF_V_DIM)
    lambda_init = 0.8 - 0.6 * math.exp(-0.3 * layer)
    f32 = jnp.float32
    lam = (jnp.exp(jnp.sum(lq1.astype(f32) * lk1.astype(f32)))
           - jnp.exp(jnp.sum(lq2.astype(f32) * lk2.astype(f32))) + lambda_init)
    out_b = differential_attention(dq, dk, dv, lam)
    out_b = rms_norm(out_b, diff_subln) * (1.0 - lambda_init)

    cos_m, sin_m = rope_mla
    q_c = (rms_norm(c_q, mla_q_norm) @ mla_w_uq).reshape(b, s, MLA_HEADS, MLA_NOPE + MLA_ROPE)
    q_c = jnp.concatenate([q_c[..., :MLA_NOPE], apply_rope(q_c[..., MLA_NOPE:], cos_m, sin_m)], axis=-1)
    kv = (rms_norm(c_kv, mla_kv_norm) @ mla_w_ukv).reshape(b, s, MLA_HEADS, MLA_NOPE + MLA_V)
    k_rot = apply_rope(k_pe[:, :, None, :], cos_m, sin_m)
    k_c = jnp.concatenate([kv[..., :MLA_NOPE],
                           jnp.broadcast_to(k_rot, (b, s, MLA_HEADS, MLA_ROPE))], axis=-1)
    out_c = causal_softmax_attention(q_c, k_c, kv[..., MLA_NOPE:])

    mixed = jnp.concatenate([out_a.reshape(b, s, -1), out_b.reshape(b, s, -1),
                             out_c.reshape(b, s, -1)], axis=-1)
    return mixed @ w_out


def setup_inputs(seed: int = 0) -> dict:
    key = jax.random.key(seed)
    ks = jax.random.split(key, 32)
    f32 = jnp.float32

    def w(k, shape, fan_in):
        return jax.random.normal(k, shape, f32) * (fan_in ** -0.5)

    def gain(k, shape):
        return 1.0 + 0.02 * jax.random.normal(k, shape, f32)

    L, D = DEPTH, D_MODEL
    return {
        'x': jax.random.normal(ks[0], (BATCH, SEQ, D), f32),
        'p': jax.random.normal(ks[1], (DEPTH, BATCH, SEQ, PLE_DIM), f32),
        'positions': jnp.broadcast_to(jnp.arange(SEQ, dtype=jnp.int32), (BATCH, SEQ)),
        'norm_ffn1': gain(ks[2], (L, D)),
        'w_ffn1_gu': w(ks[3], (L, D, 2 * D_FF), D),
        'w_ffn1_down': w(ks[4], (L, D_FF, D), D_FF),
        'norm_mix': gain(ks[5], (L, D)),
        'w_in': w(ks[6], (L, D, W_IN_COLS), D),
        'mla_q_norm': gain(ks[7], (L, MLA_Q_RANK)),
        'mla_w_uq': w(ks[8], (L, MLA_Q_RANK, MLA_HEADS * (MLA_NOPE + MLA_ROPE)), MLA_Q_RANK),
        'mla_kv_norm': gain(ks[9], (L, MLA_KV_RANK)),
        'mla_w_ukv': w(ks[10], (L, MLA_KV_RANK, MLA_HEADS * (MLA_NOPE + MLA_V)), MLA_KV_RANK),
        'diff_lambda_q1': 0.1 * jax.random.normal(ks[11], (L, DIFF_QK_DIM), f32),
        'diff_lambda_k1': 0.1 * jax.random.normal(ks[12], (L, DIFF_QK_DIM), f32),
        'diff_lambda_q2': 0.1 * jax.random.normal(ks[13], (L, DIFF_QK_DIM), f32),
        'diff_lambda_k2': 0.1 * jax.random.normal(ks[14], (L, DIFF_QK_DIM), f32),
        'diff_subln': gain(ks[15], (L, DIFF_V_DIM)),
        'w_out': w(ks[16], (L, MIX_WIDTH, D), MIX_WIDTH),
        'norm_ffn2': gain(ks[17], (L, D)),
        'w_ffn2_gu': w(ks[18], (L, D, 2 * D_FF), D),
        'w_ffn2_down': w(ks[19], (L, D_FF, D), D_FF),
        'norm_ple': gain(ks[20], (L, D)),
        'w_ple_gate': w(ks[21], (L, D, D), D),
        'w_ple_proj': w(ks[22], (L, PLE_DIM, D), PLE_DIM),
        'norm_final': gain(ks[23], (D,)),
    }


def reference(x, p, positions, norm_ffn1, w_ffn1_gu, w_ffn1_down, norm_mix, w_in, mla_q_norm,
              mla_w_uq, mla_kv_norm, mla_w_ukv, diff_lambda_q1, diff_lambda_k1, diff_lambda_q2,
              diff_lambda_k2, diff_subln, w_out, norm_ffn2, w_ffn2_gu, w_ffn2_down, norm_ple,
              w_ple_gate, w_ple_proj, norm_final):
    cos_d, sin_d = rope_tables(positions, PARTIAL_ROT)
    rope_diff = (cos_d[:, :, None, None, :], sin_d[:, :, None, None, :])
    cos_m, sin_m = rope_tables(positions, MLA_ROPE)
    rope_mla = (cos_m[:, :, None, :], sin_m[:, :, None, :])

    h = x
    for i in range(DEPTH):
        h = h + 0.5 * swiglu(rms_norm(h, norm_ffn1[i]), w_ffn1_gu[i], w_ffn1_down[i])
        h = h + token_mixing(rms_norm(h, norm_mix[i]), rope_diff, rope_mla, i, w_in[i],
                             mla_q_norm[i], mla_w_uq[i], mla_kv_norm[i], mla_w_ukv[i],
                             diff_lambda_q1[i], diff_lambda_k1[i], diff_lambda_q2[i],
                             diff_lambda_k2[i], diff_subln[i], w_out[i])
        h = h + 0.5 * swiglu(rms_norm(h, norm_ffn2[i]), w_ffn2_gu[i], w_ffn2_down[i])
        gate = jax.nn.sigmoid(rms_norm(h, norm_ple[i]) @ w_ple_gate[i])
        h = h + (p[i] @ w_ple_proj[i]) * gate
    return rms_norm(h, norm_final)
```

```cpp
#include <hip/hip_runtime.h>
#include <hip/hip_cooperative_groups.h>
#include <cstdio>
namespace cg = cooperative_groups;

#define LAS __attribute__((address_space(3)))
typedef unsigned short bf16_t;
typedef short bf16x8 __attribute__((ext_vector_type(8)));
typedef float f32x4 __attribute__((ext_vector_type(4)));
typedef float f32x16 __attribute__((ext_vector_type(16)));
typedef unsigned u32x4 __attribute__((ext_vector_type(4)));
typedef unsigned u32x2 __attribute__((ext_vector_type(2)));

constexpr int T = 16384, SEQ = 4096, D = 1024, FF = 2816, GU = 5632, NQ = 2816, QW = 2304, NL = 4;
constexpr float EPS = 1e-6f;
constexpr float LOG2E = 1.4426950408889634f, LN2 = 0.6931471805599453f;

constexpr size_t al(size_t x) { return (x + 255) & ~(size_t)255; }
constexpr size_t SZ_WGU = (size_t)GU * D * 2, SZ_WD = (size_t)D * FF * 2, SZ_WIN = (size_t)NQ * D * 2, SZ_WUP = (size_t)512 * 256 * 2,
                 SZ_WSQ = (size_t)D * D * 2, SZ_WPJ = (size_t)D * 256 * 2;
constexpr size_t WO_GU1 = 0, WO_D1 = WO_GU1 + SZ_WGU, WO_IN = WO_D1 + SZ_WD, WO_UPQ = WO_IN + SZ_WIN, WO_UPKV = WO_UPQ + SZ_WUP,
                 WO_OUT = WO_UPKV + SZ_WUP, WO_GU2 = WO_OUT + SZ_WSQ, WO_D2 = WO_GU2 + SZ_WGU, WO_GATE = WO_D2 + SZ_WD, WO_PJ = WO_GATE + SZ_WSQ,
                 SZ_WL = WO_PJ + SZ_WPJ;
constexpr size_t WS_W = 0;
constexpr size_t WS_HB = al(WS_W + NL * SZ_WL);
constexpr size_t WS_ACT = al(WS_HB + (size_t)T * D * 2);
constexpr size_t WS_QKV = WS_ACT;
constexpr size_t WS_CQ = al(WS_QKV + (size_t)T * QW * 2);
constexpr size_t WS_CKV = al(WS_CQ + (size_t)T * 256 * 2);
constexpr size_t WS_ACT_END = al(WS_CKV + (size_t)T * 256 * 2) > al(WS_ACT + (size_t)T * FF * 2) ? al(WS_CKV + (size_t)T * 256 * 2) : al(WS_ACT + (size_t)T * FF * 2);
constexpr size_t WS_MIX = WS_ACT_END;
constexpr size_t WS_PB = al(WS_MIX + (size_t)T * D * 2);
constexpr size_t WS_VTSB = al(WS_PB + (size_t)NL * T * 256 * 2);
constexpr size_t WS_VTDF = al(WS_VTSB + (size_t)16 * 64 * SEQ * 2);
constexpr size_t WS_VTML = al(WS_VTDF + (size_t)16 * 128 * SEQ * 2);
constexpr size_t WS_QM = al(WS_VTML + (size_t)16 * 64 * SEQ * 2);
constexpr size_t WS_KM = al(WS_QM + (size_t)T * 384 * 2);
constexpr size_t WS_SSQ = al(WS_KM + (size_t)T * 384 * 2);
constexpr size_t WS_SSQQ = WS_SSQ + (size_t)2 * T * 16 * 4;
constexpr size_t WS_SSQKV = WS_SSQQ + (size_t)T * 4 * 4;
constexpr size_t WS_CTR = WS_SSQKV + (size_t)T * 4 * 4;
constexpr size_t WS_BAR = al(WS_CTR + 256);
constexpr size_t WS_ROPE = al(WS_BAR + 5504 * 4);
constexpr size_t WS_STASH = al(WS_ROPE + (size_t)T * 48 * 4);
constexpr size_t WS_END = al(WS_STASH + (size_t)256 * 16 * 512 * 16);
constexpr size_t WS_HB2 = WS_VTML;
static_assert(WS_HB2 + (size_t)T * D * 2 <= WS_SSQ, "hb2 alias overflows");

struct Params { const float* in[25]; float* out; unsigned char* ws; };

typedef __bf16 bf16x2_t __attribute__((ext_vector_type(2)));
typedef float f32x2_t __attribute__((ext_vector_type(2)));
__device__ __forceinline__ unsigned cvt_pk_bf16(float lo, float hi) { f32x2_t v = {lo, hi}; bf16x2_t b = __builtin_convertvector(v, bf16x2_t); return __builtin_bit_cast(unsigned, b); }
__device__ __forceinline__ bf16_t f2bf(float f) { unsigned u = __float_as_uint(f); u += 0x7FFFu + ((u >> 16) & 1u); return (bf16_t)(u >> 16); }
__device__ __forceinline__ float bf2f(unsigned v) { return __uint_as_float(v << 16); }
__device__ __forceinline__ float fexp2(float x) { return __builtin_amdgcn_exp2f(x); }
__device__ __forceinline__ float flog2(float x) { return __builtin_amdgcn_logf(x); }
__device__ __forceinline__ float frcp(float x) { return __builtin_amdgcn_rcpf(x); }
__device__ __forceinline__ int opaque_tid() { int t = threadIdx.x; asm volatile("" : "+v"(t)); return t; }
template <class P> __device__ __forceinline__ P* opq(P* p) { unsigned z; asm volatile("s_mov_b32 %0, 0" : "=s"(z)); return (P*)((unsigned char*)p + z); }
__device__ __forceinline__ float sum16(const float* p) { const f32x4 a = *(const f32x4*)p, b = *(const f32x4*)(p + 4), c = *(const f32x4*)(p + 8), d = *(const f32x4*)(p + 12);
  return (((a[0] + a[1]) + (a[2] + a[3])) + ((b[0] + b[1]) + (b[2] + b[3]))) + (((c[0] + c[1]) + (c[2] + c[3])) + ((d[0] + d[1]) + (d[2] + d[3]))); }
__device__ __forceinline__ float sum4(const float* p) { const f32x4 a = *(const f32x4*)p; return (a[0] + a[1]) + (a[2] + a[3]); }
__device__ __forceinline__ float wave_sum(float v) {
  v += __shfl_xor(v, 32); v += __shfl_xor(v, 16); v += __shfl_xor(v, 8); v += __shfl_xor(v, 4); v += __shfl_xor(v, 2); v += __shfl_xor(v, 1); return v;
}


#define XB_TMO      128
#define XB_XCNT(j)  (256  + 64 * (j))
#define XB_XSUB(j)  (1280 + 64 * (j))
#define XB_XGEN(j)  (2304 + 64 * (j))
#define XB_TOP      3328
#define XB_TOPGEN   3392
#define XB_LSUB(j)  (3456 + 64 * (j))
#define XB_LGEN(j)  (4480 + 64 * (j))
#define XCD_BAR_WORDS 5504
#define XB_SPIN_CAP (1u << 18)
__device__ __forceinline__ unsigned xb_ld(unsigned* p)              { return __hip_atomic_load(p, __ATOMIC_RELAXED, __HIP_MEMORY_SCOPE_AGENT); }
__device__ __forceinline__ unsigned xb_add(unsigned* p, unsigned v) { return __hip_atomic_fetch_add(p, v, __ATOMIC_RELAXED, __HIP_MEMORY_SCOPE_AGENT); }
__device__ __forceinline__ unsigned xb_xcc_id() { return (unsigned)__builtin_amdgcn_s_getreg((3 << 11) | 20) & 0xFu; }
#define XB_SPIN(cond, bar) do { unsigned _sp = 0; while (cond) { __builtin_amdgcn_s_sleep(1); \
    if ((++_sp & 255u) == 0u) { if (xb_ld(&(bar)[XB_TMO])) break; if (_sp > XB_SPIN_CAP) { atomicAdd(&(bar)[XB_TMO], 1u); break; } } } } while (0)
struct XcdBarrier { unsigned* bar; unsigned x; volatile LAS unsigned* st; };
__device__ __forceinline__ XcdBarrier xcd_barrier_post(unsigned* bar, volatile LAS unsigned* st) {
  XcdBarrier b; b.bar = bar; b.x = xb_xcc_id(); b.st = st;
  if (threadIdx.x == 0) st[2] = xb_add(&bar[XB_XCNT(b.x)], 1u);
  return b;
}
__device__ __forceinline__ void xcd_barrier_complete(unsigned* bar, unsigned x, unsigned& nloc, unsigned& nx) {
  const unsigned G = gridDim.x * gridDim.y * gridDim.z;
  unsigned sum, cnt, mine, sp = 0u;
  for (;;) {
    sum = 0u; cnt = 0u; mine = 0u;
#pragma unroll
    for (unsigned j = 0; j < 16; ++j) { const unsigned c = xb_ld(&bar[XB_XCNT(j)]); sum += c; cnt += (c > 0u) ? 1u : 0u; mine = (j == x) ? c : mine; }
    if (sum == G) break;
    __builtin_amdgcn_s_sleep(1);
    if ((++sp & 255u) == 0u) { if (xb_ld(&bar[XB_TMO])) break; if (sp > XB_SPIN_CAP) { atomicAdd(&bar[XB_TMO], 1u); break; } }
  }
  nloc = mine > 0u ? mine : 1u; nx = cnt > 0u ? cnt : 1u;
}
__device__ __forceinline__ void xcd_barrier(const XcdBarrier& b) {
  asm volatile("s_waitcnt vmcnt(0)" ::: "memory");
  __syncthreads();
  if (threadIdx.x == 0) {
    unsigned* bar = b.bar;
    __builtin_amdgcn_s_waitcnt(0);
    unsigned nloc = b.st[0], nx = b.st[1];
    if (nloc == 0u) { xcd_barrier_complete(bar, b.x, nloc, nx); b.st[0] = nloc; b.st[1] = nx; }
    const unsigned old = xb_add(&bar[XB_XSUB(b.x)], 1u);
    const unsigned gen = old / nloc;
    if (old + 1u == (gen + 1u) * nloc) {
      __builtin_amdgcn_fence(__ATOMIC_RELEASE, "agent");
      asm volatile("s_waitcnt vmcnt(0)" ::: "memory");
      const unsigned og = xb_add(&bar[XB_TOP], 1u);
      const unsigned tg = og / nx;
      if (og + 1u == (tg + 1u) * nx) xb_add(&bar[XB_TOPGEN], 1u);
      else XB_SPIN(xb_ld(&bar[XB_TOPGEN]) == tg, bar);
      __builtin_amdgcn_fence(__ATOMIC_ACQUIRE, "agent");
      xb_add(&bar[XB_XGEN(b.x)], 1u);
      asm volatile("s_waitcnt vmcnt(0)" ::: "memory");
    } else {
      XB_SPIN(xb_ld(&bar[XB_XGEN(b.x)]) == gen, bar);
      __builtin_amdgcn_fence(__ATOMIC_ACQUIRE, "agent");
      asm volatile("s_waitcnt vmcnt(0)" ::: "memory");
    }
  }
  __syncthreads();
}

__device__ __forceinline__ void xcd_barrier_local(const XcdBarrier& b) {
  asm volatile("s_waitcnt vmcnt(0)" ::: "memory");
  __syncthreads();
  if (threadIdx.x == 0) {
    unsigned* bar = b.bar;
    __builtin_amdgcn_s_waitcnt(0);
    unsigned nloc = b.st[0], nx = b.st[1];
    if (nloc == 0u) { xcd_barrier_complete(bar, b.x, nloc, nx); b.st[0] = nloc; b.st[1] = nx; }
    const unsigned old = xb_add(&bar[XB_LSUB(b.x)], 1u);
    const unsigned gen = old / nloc;
    if (old + 1u == (gen + 1u) * nloc) xb_add(&bar[XB_LGEN(b.x)], 1u);
    else XB_SPIN(xb_ld(&bar[XB_LGEN(b.x)]) == gen, bar);
    __builtin_amdgcn_fence(__ATOMIC_ACQUIRE, "agent");
    asm volatile("s_waitcnt vmcnt(0)" ::: "memory");
  }
  __syncthreads();
}

namespace pg8 {
constexpr int BM = 256, BK = 64, HALF = 128, HTB = HALF * BK * 2, STAGE_BYTES = 8 * HTB, NXCD = 8, WGM = 8;
__host__ __device__ __forceinline__ int lds_byte(int r, int c) { const int st = (r >> 4) * 2 + (c >> 5), rr = r & 15, cc = c & 31, ob = rr * 64 + cc * 2; return st * 1024 + (ob ^ (((ob >> 9) & 1) << 5)); }
__host__ __device__ __forceinline__ void stage_rc(int b, int& R, int& C) { const int st = b / 1024, sb = b % 1024, swz = sb ^ (((sb >> 9) & 1) << 5); R = (st >> 1) * 16 + swz / 64; C = (st & 1) * 32 + (swz % 64) / 2; }
struct Unit { int pm, pn; };
struct Gemm { const bf16_t* A; const bf16_t* Bt; int M, N, K; };
__device__ __forceinline__ void map_tile(int L, int nM, int nN, Unit& u) {
  const int nwg = nM * nN; int wgid = L;
  { const int q = nwg / NXCD, r = nwg % NXCD, xcd = wgid % NXCD, off = wgid / NXCD; wgid = (xcd < r ? xcd * (q + 1) : r * (q + 1) + (xcd - r) * q) + off; }
  const int nig = WGM * nN, gid = wgid / nig, fm = gid * WGM, gsz = (nM - fm) < WGM ? (nM - fm) : WGM;
  u.pm = fm + ((wgid % nig) % gsz); u.pn = (wgid % nig) / gsz;
}
struct StaticOrder {
  int nM, nN, nwg, G, c;
  __device__ void init(int M, int N, int G_, int c_) { nM = M / BM; nN = N / BM; nwg = nM * nN; G = G_; c = c_; }
  __device__ bool next(int i, Unit& u) const { const long L = (long)i * G + c; if (L >= nwg || c < 0) return false; map_tile((int)L, nM, nN, u); return true; }
};

__host__ __device__ __forceinline__ int perm32(int rho) { const int n = rho >> 4, i = rho & 15; return 8 * (i >> 2) + 4 * n + (i & 3); }
template <bool PERM = false, class Epi, class Sched>
__device__ __forceinline__ void gemm_phase(LAS unsigned char* lds, const Gemm g, const Sched& S, const Epi& E) {
  const int tid = opaque_tid(), wid = __builtin_amdgcn_readfirstlane(tid >> 6), lane = tid & 63, wr = wid >> 2, wc = wid & 3, fr = lane & 15, fq = lane >> 4;
  const int K = g.K, nt = K / BK;
  unsigned voffA[2], voffB[2];
#pragma unroll
  for (int i = 0; i < 2; ++i) { int R, C; stage_rc(tid * 16 + i * 8192, R, C); const int Rb = PERM ? ((R & ~31) + perm32(R & 31)) : R;
    voffA[i] = (unsigned)(R * K + C) * 2u; voffB[i] = (unsigned)(Rb * K + C) * 2u; }
  const size_t kstep = (size_t)(BK * 2);
  const size_t hstep = (size_t)HALF * K * 2;
  const size_t tstep = 2 * hstep;
  const unsigned ldsw = (unsigned)wid * 1024u;
  const int aoff = lds_byte(wr * 64 + fr, fq * 8), boff = lds_byte(wc * 32 + fr, fq * 8);
#define PG8_SA(b, h) (((b) * 2 + (h)) * HTB)
#define PG8_SB(b, h) ((4 + (b) * 2 + (h)) * HTB)
#define PG8_STAGE(bufoff, gbase, voff) do { _Pragma("unroll") for (int _i = 0; _i < 2; ++_i) \
    __builtin_amdgcn_global_load_lds((const unsigned*)((const char*)(gbase) + (voff)[_i]), (LAS unsigned*)(lds + (bufoff) + ldsw + _i * 8192), 16, 0, 0); } while (0)
#define PG8_LDA(dst, b, h) do { _Pragma("unroll") for (int m = 0; m < 4; ++m) _Pragma("unroll") for (int k = 0; k < 2; ++k) dst[m][k] = *(const LAS bf16x8*)(lds + PG8_SA(b, h) + aoff + m * 2048 + k * 1024); } while (0)
#define PG8_LDB(dst, b, h) do { _Pragma("unroll") for (int n = 0; n < 2; ++n) _Pragma("unroll") for (int k = 0; k < 2; ++k) dst[n][k] = *(const LAS bf16x8*)(lds + PG8_SB(b, h) + boff + n * 2048 + k * 1024); } while (0)
#define PG8_MMA(ai, bj, At, Bt) do { __builtin_amdgcn_s_setprio(1); _Pragma("unroll") for (int m = 0; m < 4; ++m) _Pragma("unroll") for (int n = 0; n < 2; ++n) _Pragma("unroll") for (int k = 0; k < 2; ++k) \
    acc[ai][bj][m][n] = __builtin_amdgcn_mfma_f32_16x16x32_bf16(Bt[n][k], At[m][k], acc[ai][bj][m][n], 0, 0, 0); __builtin_amdgcn_s_setprio(0); } while (0)
#define PG8_WAIT_V(n) asm volatile("s_waitcnt vmcnt(" #n ")" ::: "memory")
#define PG8_WAIT_L(n) asm volatile("s_waitcnt lgkmcnt(" #n ")" ::: "memory")
#define PG8_BAR __builtin_amdgcn_s_barrier()
#define PG8_SCHED __builtin_amdgcn_sched_barrier(0)
  Unit cur, nxt; int ui = 0;
  if (!S.next(0, cur)) return;
  f32x4 acc[2][2][4][2];
#pragma unroll
  for (int a = 0; a < 2; ++a)
#pragma unroll
    for (int b = 0; b < 2; ++b)
#pragma unroll
      for (int m = 0; m < 4; ++m)
#pragma unroll
        for (int n = 0; n < 2; ++n) acc[a][b][m][n] = (f32x4){0.f, 0.f, 0.f, 0.f};
  bf16x8 At[4][2], B0[2][2], B1[2][2];
  const char* cA = (const char*)g.A + (size_t)cur.pm * tstep; const char* cB = (const char*)g.Bt + (size_t)cur.pn * tstep;
  PG8_STAGE(PG8_SB(0, 0), cB, voffB); PG8_STAGE(PG8_SA(0, 0), cA, voffA); PG8_STAGE(PG8_SB(0, 1), cB + hstep, voffB); PG8_STAGE(PG8_SA(0, 1), cA + hstep, voffA);
  if (wr == 1) PG8_BAR;
  PG8_WAIT_V(4); PG8_BAR;
  PG8_STAGE(PG8_SB(1, 0), cB + kstep, voffB); PG8_STAGE(PG8_SA(1, 0), cA + kstep, voffA); PG8_STAGE(PG8_SB(1, 1), cB + hstep + kstep, voffB);
  PG8_WAIT_V(6); PG8_BAR;
  for (;;) {
    const bool has_next = S.next(ui + 1, nxt);
    const char* nA = has_next ? (const char*)g.A + (size_t)nxt.pm * tstep : cA; const char* nB = has_next ? (const char*)g.Bt + (size_t)nxt.pn * tstep : cB;
#pragma unroll 1
    for (int t = 0; t < nt; t += 2) {
      const bool last = (t == nt - 2);
      const char* a1 = cA + (size_t)(t + 1) * kstep;
      const char* a2 = last ? nA : cA + (size_t)(t + 2) * kstep; const char* b2 = last ? nB : cB + (size_t)(t + 2) * kstep;
      const char* a3 = a2 + kstep; const char* b3 = b2 + kstep;
      PG8_LDB(B0, 0, 0); PG8_SCHED; PG8_LDA(At, 0, 0); PG8_STAGE(PG8_SA(1, 1), a1 + hstep, voffA);
      PG8_WAIT_L(8); PG8_BAR; PG8_WAIT_L(0); PG8_MMA(0, 0, At, B0); PG8_BAR; PG8_SCHED;
      PG8_LDB(B1, 0, 1); PG8_STAGE(PG8_SB(0, 0), b2, voffB);
      PG8_BAR; PG8_WAIT_L(0); PG8_MMA(0, 1, At, B1); PG8_BAR;
      PG8_LDA(At, 0, 1); PG8_STAGE(PG8_SA(0, 0), a2, voffA);
      PG8_BAR; PG8_WAIT_L(0); PG8_MMA(1, 0, At, B0); PG8_BAR; PG8_SCHED;
      PG8_STAGE(PG8_SB(0, 1), b2 + hstep, voffB);
      PG8_WAIT_V(6); PG8_BAR; PG8_MMA(1, 1, At, B1); PG8_BAR;
      PG8_LDB(B0, 1, 0); PG8_SCHED; PG8_LDA(At, 1, 0); PG8_STAGE(PG8_SA(0, 1), a2 + hstep, voffA);
      PG8_WAIT_L(8); PG8_BAR; PG8_WAIT_L(0); PG8_MMA(0, 0, At, B0); PG8_BAR; PG8_SCHED;
      PG8_LDB(B1, 1, 1); PG8_STAGE(PG8_SB(1, 0), b3, voffB);
      PG8_BAR; PG8_WAIT_L(0); PG8_MMA(0, 1, At, B1); PG8_BAR;
      PG8_LDA(At, 1, 1); PG8_STAGE(PG8_SA(1, 0), a3, voffA);
      PG8_BAR; PG8_WAIT_L(0); PG8_MMA(1, 0, At, B0); PG8_BAR; PG8_SCHED;
      PG8_STAGE(PG8_SB(1, 1), b3 + hstep, voffB);
      PG8_WAIT_V(6); PG8_BAR; PG8_MMA(1, 1, At, B1); PG8_BAR;
    }
    E(acc, cur, wr, wc, fr, fq);
    if (!has_next) break;
#pragma unroll
    for (int a = 0; a < 2; ++a)
#pragma unroll
      for (int b = 0; b < 2; ++b)
#pragma unroll
        for (int m = 0; m < 4; ++m)
#pragma unroll
          for (int n = 0; n < 2; ++n) acc[a][b][m][n] = (f32x4){0.f, 0.f, 0.f, 0.f};
    cur = nxt; cA = nA; cB = nB; ++ui;
  }
  PG8_WAIT_V(0);
  if (wr == 0) PG8_BAR;
  PG8_BAR;
#undef PG8_SA
#undef PG8_SB
#undef PG8_STAGE
#undef PG8_LDA
#undef PG8_LDB
#undef PG8_MMA
#undef PG8_WAIT_V
#undef PG8_WAIT_L
#undef PG8_BAR
#undef PG8_SCHED
}
}
using pg8::Unit;

#define EPI_ROWS(...) _Pragma("unroll") for (int ai = 0; ai < 2; ++ai) _Pragma("unroll") for (int m = 0; m < 4; ++m) { const int row = u.pm * 256 + ai * 128 + wr * 64 + m * 16 + fr; __VA_ARGS__ }

__device__ __forceinline__ f32x4 load_bf4(const bf16_t* p) { const u32x2 w = *(const u32x2*)p; f32x4 v; v[0] = __uint_as_float(w.x << 16); v[1] = __uint_as_float(w.x & 0xffff0000u); v[2] = __uint_as_float(w.y << 16); v[3] = __uint_as_float(w.y & 0xffff0000u); return v; }
__device__ __forceinline__ void store_bf4(bf16_t* p, f32x4 v) { u32x2 w; w.x = cvt_pk_bf16(v[0], v[1]); w.y = cvt_pk_bf16(v[2], v[3]); *(u32x2*)p = w; }
__device__ __forceinline__ int vt_pos(int w) { return 8 * ((w >> 2) & 1) + 4 * (w >> 3) + (w & 3); }

__device__ __forceinline__ void load_bf8(const bf16_t* p, f32x4& a, f32x4& b) { const u32x4 w = *(const u32x4*)p;
  a[0] = __uint_as_float(w.x << 16); a[1] = __uint_as_float(w.x & 0xffff0000u); a[2] = __uint_as_float(w.y << 16); a[3] = __uint_as_float(w.y & 0xffff0000u);
  b[0] = __uint_as_float(w.z << 16); b[1] = __uint_as_float(w.z & 0xffff0000u); b[2] = __uint_as_float(w.w << 16); b[3] = __uint_as_float(w.w & 0xffff0000u); }
__device__ __forceinline__ void store_bf8(bf16_t* p, const f32x4& a, const f32x4& b) { u32x4 w; w.x = cvt_pk_bf16(a[0], a[1]); w.y = cvt_pk_bf16(a[2], a[3]); w.z = cvt_pk_bf16(b[0], b[1]); w.w = cvt_pk_bf16(b[2], b[3]); *(u32x4*)p = w; }
struct EpiGU {
  const float* ssq; bf16_t* act;
  __device__ __forceinline__ void operator()(const f32x4 (&acc)[2][2][4][2], const Unit& u, int wr, int wc, int fr, int fq) const {
    EPI_ROWS(
      const float rs = rsqrtf(sum16(ssq + (size_t)row * 16) * (1.0f / D) + EPS);
      f32x4 o[2];
      _Pragma("unroll") for (int n = 0; n < 2; ++n) {
        const f32x4 g = acc[ai][0][m][n] * rs, v = acc[ai][1][m][n] * rs;
        _Pragma("unroll") for (int j = 0; j < 4; ++j) o[n][j] = g[j] * frcp(1.0f + fexp2(-g[j] * LOG2E)) * v[j]; }
      {
        u32x4 w; w.x = cvt_pk_bf16(o[0][0], o[0][1]); w.y = cvt_pk_bf16(o[0][2], o[0][3]); w.z = cvt_pk_bf16(o[1][0], o[1][1]); w.w = cvt_pk_bf16(o[1][2], o[1][3]);
        __builtin_nontemporal_store(w, (u32x4*)(act + (size_t)row * FF + u.pn * 128 + wc * 32 + fq * 8)); }
    )
  }
};
struct EpiRes {
  const float* rin_f; const bf16_t* rin_b; bf16_t* hb; float* ssq_out; float scale;
  __device__ __forceinline__ void operator()(const f32x4 (&acc)[2][2][4][2], const Unit& u, int wr, int wc, int fr, int fq) const {
    EPI_ROWS(
      const size_t off = (size_t)row * D + u.pn * 256 + wc * 32 + fq * 4; float sq = 0.f;
      _Pragma("unroll") for (int bj = 0; bj < 2; ++bj) _Pragma("unroll") for (int n = 0; n < 2; ++n) {
        const size_t o2 = off + bj * 128 + n * 16;
        f32x4 hv = rin_f ? *(const f32x4*)(rin_f + o2) : load_bf4(rin_b + o2); hv += acc[ai][bj][m][n] * scale;
        store_bf4(hb + o2, hv);
        sq += hv[0] * hv[0] + hv[1] * hv[1] + hv[2] * hv[2] + hv[3] * hv[3]; }
      sq += __shfl_xor(sq, 16); sq += __shfl_xor(sq, 32);
      if (fq == 0) ssq_out[(size_t)row * 16 + u.pn * 4 + wc] = sq;
    )
  }
};
struct EpiPle {
  const float* ssq_in; const bf16_t* proj; const bf16_t* rin; bf16_t* hb; float* ssq_out;
  __device__ __forceinline__ void operator()(const f32x4 (&acc)[2][2][4][2], const Unit& u, int wr, int wc, int fr, int fq) const {
    EPI_ROWS(
      const float rs = rsqrtf(sum16(ssq_in + (size_t)row * 16) * (1.0f / D) + EPS);
      const size_t off = (size_t)row * D + u.pn * 256 + wc * 32 + fq * 4; float sq = 0.f;
      _Pragma("unroll") for (int bj = 0; bj < 2; ++bj) _Pragma("unroll") for (int n = 0; n < 2; ++n) {
        const size_t o2 = off + bj * 128 + n * 16;
        f32x4 hv = load_bf4(rin + o2); const f32x4 pr = load_bf4(proj + o2);
        _Pragma("unroll") for (int j = 0; j < 4; ++j) { const float gt = frcp(1.0f + fexp2(-acc[ai][bj][m][n][j] * rs * LOG2E)); hv[j] += pr[j] * gt; }
        store_bf4(hb + o2, hv);
        sq += hv[0] * hv[0] + hv[1] * hv[1] + hv[2] * hv[2] + hv[3] * hv[3]; }
      sq += __shfl_xor(sq, 16); sq += __shfl_xor(sq, 32);
      if (fq == 0) ssq_out[(size_t)row * 16 + u.pn * 4 + wc] = sq;
    )
  }
};
struct EpiResP {
  const float* rin_f; const bf16_t* rin_b; bf16_t* hb; float* ssq_out; float scale;
  __device__ __forceinline__ void operator()(const f32x4 (&acc)[2][2][4][2], const Unit& u, int wr, int wc, int fr, int fq) const {
    EPI_ROWS(
      const size_t off = (size_t)row * D + u.pn * 256 + wc * 32 + fq * 8; float sq = 0.f;
      _Pragma("unroll") for (int bj = 0; bj < 2; ++bj) {
        const size_t o2 = off + bj * 128; f32x4 h0; f32x4 h1;
        if (rin_f) { h0 = *(const f32x4*)(rin_f + o2); h1 = *(const f32x4*)(rin_f + o2 + 4); } else load_bf8(rin_b + o2, h0, h1);
        h0 += acc[ai][bj][m][0] * scale; h1 += acc[ai][bj][m][1] * scale;
        store_bf8(hb + o2, h0, h1);
        sq += (h0[0] * h0[0] + h0[1] * h0[1] + h0[2] * h0[2] + h0[3] * h0[3]) + (h1[0] * h1[0] + h1[1] * h1[1] + h1[2] * h1[2] + h1[3] * h1[3]); }
      sq += __shfl_xor(sq, 16); sq += __shfl_xor(sq, 32);
      if (fq == 0) ssq_out[(size_t)row * 16 + u.pn * 4 + wc] = sq;
    )
  }
};
struct EpiPleP {
  const float* ssq_in; const bf16_t* proj; const bf16_t* rin; bf16_t* hb; float* ssq_out;
  __device__ __forceinline__ void operator()(const f32x4 (&acc)[2][2][4][2], const Unit& u, int wr, int wc, int fr, int fq) const {
    EPI_ROWS(
      const float rs = rsqrtf(sum16(ssq_in + (size_t)row * 16) * (1.0f / D) + EPS);
      const size_t off = (size_t)row * D + u.pn * 256 + wc * 32 + fq * 8; float sq = 0.f;
      _Pragma("unroll") for (int bj = 0; bj < 2; ++bj) {
        const size_t o2 = off + bj * 128; f32x4 h0; f32x4 h1; f32x4 p0; f32x4 p1;
        load_bf8(rin + o2, h0, h1); load_bf8(proj + o2, p0, p1);
        _Pragma("unroll") for (int j = 0; j < 4; ++j) {
          h0[j] += p0[j] * frcp(1.0f + fexp2(-acc[ai][bj][m][0][j] * rs * LOG2E));
          h1[j] += p1[j] * frcp(1.0f + fexp2(-acc[ai][bj][m][1][j] * rs * LOG2E)); }
        store_bf8(hb + o2, h0, h1);
        sq += (h0[0] * h0[0] + h0[1] * h0[1] + h0[2] * h0[2] + h0[3] * h0[3]) + (h1[0] * h1[0] + h1[1] * h1[1] + h1[2] * h1[2] + h1[3] * h1[3]); }
      sq += __shfl_xor(sq, 16); sq += __shfl_xor(sq, 32);
      if (fq == 0) ssq_out[(size_t)row * 16 + u.pn * 4 + wc] = sq;
    )
  }
};
struct EpiProj {
  bf16_t* proj;
  __device__ __forceinline__ void operator()(const f32x4 (&acc)[2][2][4][2], const Unit& u, int wr, int wc, int fr, int fq) const {
    EPI_ROWS(
      const size_t off = (size_t)row * D + u.pn * 256 + wc * 32 + fq * 4;
      _Pragma("unroll") for (int bj = 0; bj < 2; ++bj) _Pragma("unroll") for (int n = 0; n < 2; ++n) store_bf4(proj + off + bj * 128 + n * 16, acc[ai][bj][m][n]);
    )
  }
};
struct EpiWin {
  const float* ssq_in; bf16_t* qkv; bf16_t* cq; bf16_t* ckv; bf16_t* vtsb; bf16_t* vtdf; float* ssqq; float* ssqkv; const float* cosd; const float* sind;
  __device__ __forceinline__ void operator()(const f32x4 (&acc)[2][2][4][2], const Unit& u, int wr, int wc, int fr, int fq) const {
    const int pn = u.pn;
    EPI_ROWS(
      const float rs = rsqrtf(sum16(ssq_in + (size_t)row * 16) * (1.0f / D) + EPS);
      if (pn == 2 || pn == 7 || pn == 8) {
        const int b = row >> 12, s = row & 4095, pos = (s & ~15) + vt_pos(s & 15);
        _Pragma("unroll") for (int bj = 0; bj < 2; ++bj) _Pragma("unroll") for (int n = 0; n < 2; ++n) {
          const int c = pn * 256 + bj * 128 + wc * 32 + n * 16 + fq * 4; const f32x4 v = acc[ai][bj][m][n] * rs;
          bf16_t* base;
          if (pn == 2) { const int cc = c - 512; base = vtsb + ((size_t)((b * 4 + (cc >> 6)) * 64 + (cc & 63))) * SEQ + pos; }
          else { const int cc = c - 1792; base = vtdf + ((size_t)((b * 4 + (cc >> 7)) * 128 + (cc & 127))) * SEQ + pos; }
          _Pragma("unroll") for (int j = 0; j < 4; ++j) base[(size_t)j * SEQ] = f2bf(v[j]);
        }
      } else if (pn >= 9) {
        bf16_t* dst = (pn == 9 ? cq : ckv) + (size_t)row * 256 + wc * 32 + fq * 4; float sq = 0.f;
        _Pragma("unroll") for (int bj = 0; bj < 2; ++bj) _Pragma("unroll") for (int n = 0; n < 2; ++n) {
          const f32x4 v = acc[ai][bj][m][n] * rs; store_bf4(dst + bj * 128 + n * 16, v);
          if (pn == 9 || bj == 0) sq += v[0] * v[0] + v[1] * v[1] + v[2] * v[2] + v[3] * v[3]; }
        sq += __shfl_xor(sq, 16); sq += __shfl_xor(sq, 32);
        if (fq == 0) (pn == 9 ? ssqq : ssqkv)[(size_t)row * 4 + wc] = sq;
      } else {
        bf16_t* dst = qkv + (size_t)row * QW + pn * 256 + wc * 32 + fq * 4;
        const bool rot = pn >= 3 && pn <= 6 && (wc & 1) == 0;
        f32x4 cs4 = {1.f, 1.f, 1.f, 1.f}, sn4 = {0.f, 0.f, 0.f, 0.f};
        if (rot) { cs4 = *(const f32x4*)(cosd + (size_t)row * 8 + (fq & 1) * 4); sn4 = *(const f32x4*)(sind + (size_t)row * 8 + (fq & 1) * 4); if (fq < 2) sn4 = -sn4; }
        _Pragma("unroll") for (int bj = 0; bj < 2; ++bj) _Pragma("unroll") for (int n = 0; n < 2; ++n) {
          f32x4 v = acc[ai][bj][m][n] * rs;
          if (n == 0 && rot) { f32x4 pr; _Pragma("unroll") for (int j = 0; j < 4; ++j) pr[j] = __shfl_xor(v[j], 32); v = v * cs4 + pr * sn4; }
          store_bf4(dst + bj * 128 + n * 16, v);
        }
      }
    )
  }
};
struct EpiUpQ {
  const float* ssqq; bf16_t* qm; const float* cosm; const float* sinm;
  __device__ __forceinline__ void operator()(const f32x4 (&acc)[2][2][4][2], const Unit& u, int wr, int wc, int fr, int fq) const {
    EPI_ROWS(
      const float rs = rsqrtf(sum4(ssqq + (size_t)row * 4) * (1.0f / 256) + EPS);
      _Pragma("unroll") for (int bj = 0; bj < 2; ++bj) {
        const int G = u.pn * 8 + bj * 4 + wc;
        if (G < 12) {
          bf16_t* dst = qm + (size_t)row * 384 + G * 32 + fq * 4;
          f32x4 x1 = acc[ai][bj][m][0] * rs, x2 = acc[ai][bj][m][1] * rs;
          if (G % 3 == 2) {
            const f32x4 c = *(const f32x4*)(cosm + (size_t)row * 16 + fq * 4), s = *(const f32x4*)(sinm + (size_t)row * 16 + fq * 4);
            const f32x4 o1 = x1 * c - x2 * s, o2 = x2 * c + x1 * s; x1 = o1; x2 = o2;
          }
          store_bf4(dst, x1); store_bf4(dst + 16, x2);
        }
      }
    )
  }
};
struct EpiUpKV {
  const float* ssqkv; bf16_t* km; bf16_t* vtml;
  __device__ __forceinline__ void operator()(const f32x4 (&acc)[2][2][4][2], const Unit& u, int wr, int wc, int fr, int fq) const {
    EPI_ROWS(
      const float rs = rsqrtf(sum4(ssqkv + (size_t)row * 4) * (1.0f / 128) + EPS);
      const int b = row >> 12, s = row & 4095, pos = (s & ~15) + vt_pos(s & 15);
      _Pragma("unroll") for (int bj = 0; bj < 2; ++bj) _Pragma("unroll") for (int n = 0; n < 2; ++n) {
        const int c = bj * 128 + wc * 32 + n * 16 + fq * 4; const f32x4 v = acc[ai][bj][m][n] * rs;
        if (u.pn == 0) store_bf4(km + (size_t)row * 384 + (c >> 6) * 96 + (c & 63), v);
        else { bf16_t* base = vtml + ((size_t)((b * 4 + (c >> 6)) * 64 + (c & 63))) * SEQ + pos;
          _Pragma("unroll") for (int j = 0; j < 4; ++j) base[(size_t)j * SEQ] = f2bf(v[j]); }
      }
    )
  }
};

constexpr int LDS_K = 0, LDS_V = 16384;

template <int DQK, int DV, bool SB>
__device__ __forceinline__ void attn_pass(LAS unsigned char* lds, const bf16_t* Qg, int ldq, const bf16_t* Kg, int ldk, const bf16_t* VTg, int q0, float sc,
                                          f32x16 (&o)[DV / 32], float& lsum) {
  constexpr int KS = (DQK + 8) * 2, VS = 144, CK = DQK / 8, NKL = (64 * CK + 511) / 512, NVL = DV / 64, NKK = DQK / 16;
  const int tid = opaque_tid(), wid = tid >> 6, lane = tid & 63, l31 = lane & 31, hh = lane >> 5;
  const int qrow = q0 + wid * 32 + l31, qmin = q0 + wid * 32, qmax = qmin + 31;
  bf16x8 qf[NKK];
#pragma unroll
  for (int kk = 0; kk < NKK; ++kk) qf[kk] = *(const bf16x8*)(Qg + (size_t)qrow * ldq + kk * 16 + hh * 8);
#pragma unroll
  for (int db = 0; db < DV / 32; ++db)
#pragma unroll
    for (int r = 0; r < 16; ++r) o[db][r] = 0.f;
  float mrun = -INFINITY, lrun = 0.f, carry = 0.f;
  const int nt = (q0 + 256) / 64;
  u32x4 kreg[NKL], vreg[NVL];
  auto gload = [&](int k0) {
#pragma unroll
    for (int i = 0; i < NKL; ++i) { const int idx = tid + i * 512; if (idx < 64 * CK) { const int row = idx / CK, ch = idx % CK; kreg[i] = *(const u32x4*)(Kg + (size_t)(k0 + row) * ldk + ch * 8); } }
#pragma unroll
    for (int i = 0; i < NVL; ++i) { const int idx = tid + i * 512; const int d = idx >> 3, ch = idx & 7; vreg[i] = *(const u32x4*)(VTg + (size_t)d * SEQ + k0 + ch * 8); }
  };
  gload(SB ? (nt - 1) * 64 : 0);
  for (int it = 0; it < nt; ++it) {
    const int k0 = (SB ? (nt - 1 - it) : it) * 64;
    if (SB) {
      const bool wdone = (k0 + 64 <= qmax) && __all(carry < -110.0f);
      if (__syncthreads_and(wdone)) break;
    } else __syncthreads();
#pragma unroll
    for (int i = 0; i < NKL; ++i) { const int idx = tid + i * 512; if (idx < 64 * CK) { const int row = idx / CK, ch = idx % CK; *(LAS u32x4*)(lds + LDS_K + row * KS + ch * 16) = kreg[i]; } }
#pragma unroll
    for (int i = 0; i < NVL; ++i) { const int idx = tid + i * 512; const int d = idx >> 3, ch = idx & 7; *(LAS u32x4*)(lds + LDS_V + d * VS + ch * 16) = vreg[i]; }
    __syncthreads();
    if (it + 1 < nt) gload((SB ? (nt - 2 - it) : (it + 1)) * 64);
    if (k0 <= qmax) {
      f32x16 s[2];
#pragma unroll
      for (int kb = 0; kb < 2; ++kb) {
#pragma unroll
        for (int r = 0; r < 16; ++r) s[kb][r] = 0.f;
#pragma unroll
        for (int kk = 0; kk < NKK; ++kk) {
          const bf16x8 a = *(const LAS bf16x8*)(lds + LDS_K + (kb * 32 + l31) * KS + (kk * 16 + hh * 8) * 2);
          s[kb] = __builtin_amdgcn_mfma_f32_32x32x16_bf16(a, qf[kk], s[kb], 0, 0, 0);
        }
      }
      const bool diag = (k0 + 63 >= qmin);
      if (!SB) {
        float mx = -INFINITY;
        if (diag) {
#pragma unroll
          for (int kb = 0; kb < 2; ++kb)
#pragma unroll
            for (int r = 0; r < 16; ++r) { const int key = k0 + kb * 32 + 8 * (r >> 2) + 4 * hh + (r & 3); if (key > qrow) s[kb][r] = -INFINITY; }
        }
#pragma unroll
        for (int kb = 0; kb < 2; ++kb)
#pragma unroll
          for (int r = 0; r < 16; ++r) mx = fmaxf(mx, s[kb][r]);
        mx = fmaxf(mx, __shfl_xor(mx, 32));
        const float mnew = fmaxf(mrun, mx);
        if (!__all(mnew == mrun)) {
          const float alpha = fexp2((mrun - mnew) * sc);
          lrun *= alpha;
#pragma unroll
          for (int db = 0; db < DV / 32; ++db)
#pragma unroll
            for (int r = 0; r < 16; ++r) o[db][r] *= alpha;
          mrun = mnew;
        }
        const float msc = -mnew * sc;
#pragma unroll
        for (int kb = 0; kb < 2; ++kb)
#pragma unroll
          for (int r = 0; r < 16; ++r) { const float pv = fexp2(__builtin_fmaf(s[kb][r], sc, msc)); s[kb][r] = pv; lrun += pv; }
      } else {
        float lk[2][16];
#pragma unroll
        for (int kb = 0; kb < 2; ++kb)
#pragma unroll
          for (int r = 0; r < 16; ++r) {
            const float z = s[kb][r] * sc;
            const float e = fexp2(-fabsf(z) * LOG2E);
            const float lb = fminf(z, 0.f) - flog2(1.0f + e) * LN2;
            bool valid = true;
            if (diag) { const int key = k0 + kb * 32 + 8 * (r >> 2) + 4 * hh + (r & 3); valid = key < qrow; }
            s[kb][r] = valid ? lb : -INFINITY; lk[kb][r] = valid ? lb - z : 0.f;
          }
        float run = carry;
#pragma unroll
        for (int kb = 1; kb >= 0; --kb)
#pragma unroll
          for (int g = 3; g >= 0; --g) {
            const float G = (lk[kb][4 * g] + lk[kb][4 * g + 1]) + (lk[kb][4 * g + 2] + lk[kb][4 * g + 3]);
            const float Gp = __shfl_xor(G, 32);
            float bt = run + (hh == 0 ? Gp : 0.f);
            s[kb][4 * g + 3] = fexp2((s[kb][4 * g + 3] + bt) * LOG2E); bt += lk[kb][4 * g + 3];
            s[kb][4 * g + 2] = fexp2((s[kb][4 * g + 2] + bt) * LOG2E); bt += lk[kb][4 * g + 2];
            s[kb][4 * g + 1] = fexp2((s[kb][4 * g + 1] + bt) * LOG2E); bt += lk[kb][4 * g + 1];
            s[kb][4 * g + 0] = fexp2((s[kb][4 * g + 0] + bt) * LOG2E);
            run += G + Gp;
          }
        carry = run;
      }
#pragma unroll
      for (int kb = 0; kb < 2; ++kb)
#pragma unroll
        for (int s2 = 0; s2 < 2; ++s2) {
          u32x4 pw;
          pw.x = cvt_pk_bf16(s[kb][8 * s2 + 0], s[kb][8 * s2 + 1]); pw.y = cvt_pk_bf16(s[kb][8 * s2 + 2], s[kb][8 * s2 + 3]);
          pw.z = cvt_pk_bf16(s[kb][8 * s2 + 4], s[kb][8 * s2 + 5]); pw.w = cvt_pk_bf16(s[kb][8 * s2 + 6], s[kb][8 * s2 + 7]);
          const bf16x8 pf = __builtin_bit_cast(bf16x8, pw);
#pragma unroll
          for (int db = 0; db < DV / 32; ++db) {
            const bf16x8 a = *(const LAS bf16x8*)(lds + LDS_V + (db * 32 + l31) * VS + (kb * 32 + s2 * 16 + hh * 8) * 2);
            o[db] = __builtin_amdgcn_mfma_f32_32x32x16_bf16(a, pf, o[db], 0, 0, 0);
          }
        }
    }
  }
  lsum = lrun + __shfl_xor(lrun, 32);
}

constexpr int LDS_OUT = 49152;
template <int NDB>
__device__ __forceinline__ void attn_store(LAS unsigned char* lds, bf16_t* mixed, int tok0w, int col0, const f32x16 (&o)[NDB], int wid, int lane) {
  constexpr int RS = NDB * 64 + 16, CPR = NDB * 4;
  LAS unsigned char* reg = lds + LDS_OUT + wid * (32 * 272);
  const int l31 = lane & 31, hh = lane >> 5;
#pragma unroll
  for (int db = 0; db < NDB; ++db)
#pragma unroll
    for (int g = 0; g < 4; ++g) {
      u32x2 w; w.x = cvt_pk_bf16(o[db][4 * g], o[db][4 * g + 1]); w.y = cvt_pk_bf16(o[db][4 * g + 2], o[db][4 * g + 3]);
      *(LAS u32x2*)(reg + l31 * RS + (db * 32 + 8 * g + 4 * hh) * 2) = w;
    }
  asm volatile("s_waitcnt lgkmcnt(0)" ::: "memory");
#pragma unroll
  for (int i = 0; i < 32 * CPR / 64; ++i) {
    const int idx = i * 64 + lane, row = idx / CPR, ch = idx % CPR;
    const u32x4 w = *(const LAS u32x4*)(reg + row * RS + ch * 16);
    *(u32x4*)(mixed + (size_t)(tok0w + row) * D + col0 + ch * 8) = w;
  }
}

__device__ const unsigned char ATT_ORDER[48] = {
  31, 30, 29, 28, 27, 26, 25, 24, 23, 22, 21, 20, 19, 18, 15, 14, 13, 12, 11, 10, 9, 8, 7, 6, 5, 4, 3, 2, 17, 1, 16, 0, 47, 46, 45, 44, 43, 42, 41, 40, 39, 38, 37, 36, 35, 34, 33, 32
};

__device__ __forceinline__ void attn_phase(const Params& p, int layer, LAS unsigned char* lds, int* ctr, unsigned* up_done) {
  bool mla_ready = false;
  LAS int* slot = (LAS int*)(lds + 40960);
  for (;;) {
    unsigned char* ws = opq(p.ws);
    const bf16_t* qkv = (const bf16_t*)(ws + WS_QKV);
    bf16_t* mixed = (bf16_t*)(ws + WS_MIX);
    const int tid = opaque_tid(), wid = tid >> 6, lane = tid & 63, l31 = lane & 31, hh = lane >> 5;
    __syncthreads();
    if (tid == 0) *slot = atomicAdd(ctr, 1);
    __syncthreads();
    const int item = *slot;
    if (item >= 768) break;
    const int e = ATT_ORDER[item >> 4], type = e >> 4, qb = e & 15, bh = item & 15, b = bh >> 2, head = bh & 3;
    const int q0 = qb * 256, tok = b * SEQ + q0 + wid * 32 + l31;
    if (type == 2 && !mla_ready) {
      if (tid == 0) { unsigned sp = 0;
        while (__hip_atomic_load(up_done, __ATOMIC_RELAXED, __HIP_MEMORY_SCOPE_AGENT) < gridDim.x) { __builtin_amdgcn_s_sleep(2); if (++sp > (1u << 22)) break; }
        __builtin_amdgcn_fence(__ATOMIC_ACQUIRE, "agent"); asm volatile("s_waitcnt vmcnt(0)" ::: "memory"); }
      __syncthreads();
      mla_ready = true;
    }
    if (type == 0) {
      f32x16 o[2]; float l;
      attn_pass<64, 64, true>(lds, qkv + (size_t)b * SEQ * QW + head * 64, QW, qkv + (size_t)b * SEQ * QW + 256 + head * 64, QW,
                              (const bf16_t*)(ws + WS_VTSB) + (size_t)bh * 64 * SEQ, q0, 0.125f, o, l);
      attn_store<2>(lds, mixed, tok - l31, head * 64, o, wid, lane);
    } else if (type == 1) {
      const float* lq1 = p.in[12] + layer * 64; const float* lk1 = p.in[13] + layer * 64; const float* lq2 = p.in[14] + layer * 64; const float* lk2 = p.in[15] + layer * 64;
      const float linit = 0.8f - 0.6f * expf(-0.3f * (float)layer);
      const float lam = expf(wave_sum(lq1[lane] * lk1[lane])) - expf(wave_sum(lq2[lane] * lk2[lane])) + linit;
      f32x16 o1[4]; float l1, l2;
      const bf16_t* vt = (const bf16_t*)(ws + WS_VTDF) + (size_t)bh * 128 * SEQ;
      f32x4* stash = (f32x4*)(ws + WS_STASH) + (size_t)blockIdx.x * 16 * 512 + tid;
      attn_pass<64, 128, false>(lds, qkv + (size_t)b * SEQ * QW + 768 + head * 128, QW, qkv + (size_t)b * SEQ * QW + 1280 + head * 128, QW, vt, q0, 0.125f * LOG2E, o1, l1);
      { const float inv = 1.0f / l1;
#pragma unroll
        for (int db = 0; db < 4; ++db)
#pragma unroll
          for (int g = 0; g < 4; ++g) { f32x4 v; v[0] = o1[db][4 * g] * inv; v[1] = o1[db][4 * g + 1] * inv; v[2] = o1[db][4 * g + 2] * inv; v[3] = o1[db][4 * g + 3] * inv; stash[(db * 4 + g) * 512] = v; } }
      attn_pass<64, 128, false>(lds, qkv + (size_t)b * SEQ * QW + 768 + head * 128 + 64, QW, qkv + (size_t)b * SEQ * QW + 1280 + head * 128 + 64, QW, vt, q0, 0.125f * LOG2E, o1, l2);
      { const float inv = lam / l2; float sq = 0.f;
#pragma unroll
        for (int db = 0; db < 4; ++db)
#pragma unroll
          for (int g = 0; g < 4; ++g) { const f32x4 a = stash[(db * 4 + g) * 512];
#pragma unroll
            for (int j = 0; j < 4; ++j) { const float v = a[j] - o1[db][4 * g + j] * inv; o1[db][4 * g + j] = v; sq += v * v; } }
        sq += __shfl_xor(sq, 32);
        const float rs = rsqrtf(sq * (1.0f / 128) + EPS) * (1.0f - linit);
        const float* gsub = p.in[16] + layer * 128;
#pragma unroll
        for (int db = 0; db < 4; ++db)
#pragma unroll
          for (int g = 0; g < 4; ++g) { const f32x4 gv = *(const f32x4*)(gsub + db * 32 + 8 * g + 4 * hh);
#pragma unroll
            for (int j = 0; j < 4; ++j) o1[db][4 * g + j] *= rs * gv[j]; } }
      attn_store<4>(lds, mixed, tok - l31, 256 + head * 128, o1, wid, lane);
    } else {
      f32x16 o[2]; float l;
      attn_pass<96, 64, false>(lds, (const bf16_t*)(ws + WS_QM) + (size_t)b * SEQ * 384 + head * 96, 384, (const bf16_t*)(ws + WS_KM) + (size_t)b * SEQ * 384 + head * 96, 384,
                               (const bf16_t*)(ws + WS_VTML) + (size_t)bh * 64 * SEQ, q0, 0.10206207261596577f * LOG2E, o, l);
      const float inv = 1.0f / l;
#pragma unroll
      for (int db = 0; db < 2; ++db)
#pragma unroll
        for (int r = 0; r < 16; ++r) o[db][r] *= inv;
      attn_store<2>(lds, mixed, tok - l31, 768 + head * 64, o, wid, lane);
    }
  }
}

struct WDesc { const float* src; bf16_t* dst; const float* gain; int K, Kpad, Nsrc, Npad, mode; };
__device__ __forceinline__ void get_wdesc(const Params& p, int layer, int kind, WDesc& d) {
  unsigned char* wl = p.ws + WS_W + (size_t)layer * SZ_WL;
  d.gain = nullptr; d.mode = 0;
  switch (kind) {
    case 0: d.src = p.in[4] + (size_t)layer * D * GU; d.dst = (bf16_t*)(wl + WO_GU1); d.gain = p.in[3] + layer * D; d.K = D; d.Kpad = D; d.Nsrc = GU; d.Npad = GU; d.mode = 1; break;
    case 1: d.src = p.in[5] + (size_t)layer * FF * D; d.dst = (bf16_t*)(wl + WO_D1); d.K = FF; d.Kpad = FF; d.Nsrc = D; d.Npad = D; break;
    case 2: d.src = p.in[7] + (size_t)layer * D * 2720; d.dst = (bf16_t*)(wl + WO_IN); d.gain = p.in[6] + layer * D; d.K = D; d.Kpad = D; d.Nsrc = 2720; d.Npad = NQ; break;
    case 3: d.src = p.in[9] + (size_t)layer * 256 * 384; d.dst = (bf16_t*)(wl + WO_UPQ); d.gain = p.in[8] + layer * 256; d.K = 256; d.Kpad = 256; d.Nsrc = 384; d.Npad = 512; break;
    case 4: d.src = p.in[11] + (size_t)layer * 128 * 512; d.dst = (bf16_t*)(wl + WO_UPKV); d.gain = p.in[10] + layer * 128; d.K = 128; d.Kpad = 256; d.Nsrc = 512; d.Npad = 512; d.mode = 2; break;
    case 5: d.src = p.in[17] + (size_t)layer * D * D; d.dst = (bf16_t*)(wl + WO_OUT); d.K = D; d.Kpad = D; d.Nsrc = D; d.Npad = D; break;
    case 6: d.src = p.in[19] + (size_t)layer * D * GU; d.dst = (bf16_t*)(wl + WO_GU2); d.gain = p.in[18] + layer * D; d.K = D; d.Kpad = D; d.Nsrc = GU; d.Npad = GU; d.mode = 1; break;
    case 7: d.src = p.in[20] + (size_t)layer * FF * D; d.dst = (bf16_t*)(wl + WO_D2); d.K = FF; d.Kpad = FF; d.Nsrc = D; d.Npad = D; break;
    case 8: d.src = p.in[22] + (size_t)layer * D * D; d.dst = (bf16_t*)(wl + WO_GATE); d.gain = p.in[21] + layer * D; d.K = D; d.Kpad = D; d.Nsrc = D; d.Npad = D; break;
    default: d.src = p.in[23] + (size_t)layer * 256 * D; d.dst = (bf16_t*)(wl + WO_PJ); d.K = 256; d.Kpad = 256; d.Nsrc = D; d.Npad = D; break;
  }
}
__device__ __forceinline__ int wsrc_col(int mode, int n, int Nsrc) {
  if (mode == 1) return ((n >> 7) & 1) * FF + (n >> 8) * 128 + (n & 127);
  if (mode == 2) return n < 256 ? (n >> 6) * 128 + (n & 63) : ((n - 256) >> 6) * 128 + 64 + (n & 63);
  return n < Nsrc ? n : -1;
}

__device__ __forceinline__ void prologue(const Params& p, LAS unsigned char* lds) {
  const int tid = opaque_tid(), nb = gridDim.x, bid = blockIdx.x;
  unsigned char* ws = p.ws;
  if (bid == 0 && tid < 64) ((int*)(ws + WS_CTR))[tid] = 0;
  { float* cosd = (float*)(ws + WS_ROPE); float* sind = cosd + T * 8; float* cosm = sind + T * 8; float* sinm = cosm + T * 16;
    const int* pos = (const int*)p.in[2];
    for (int i = bid * 512 + tid; i < T * 24; i += nb * 512) {
      int tok, j; float invf;
      if (i < T * 8) { tok = i >> 3; j = i & 7; invf = 1.0f / powf(500000.0f, (float)(2 * j) / 16.0f); }
      else { const int k = i - T * 8; tok = k >> 4; j = k & 15; invf = 1.0f / powf(500000.0f, (float)(2 * j) / 32.0f); }
      const float ang = (float)pos[tok] * invf;
      double rev = (double)ang * 0.15915494309189535; rev -= rint(rev);
      const float rr = (float)(rev * 6.283185307179586);
      const float c = __cosf(rr), s = __sinf(rr);
      if (i < T * 8) { cosd[tok * 8 + j] = c; sind[tok * 8 + j] = s; } else { cosm[tok * 16 + j] = c; sinm[tok * 16 + j] = s; }
    } }
  { const f32x4* src = (const f32x4*)p.in[1]; u32x2* dst = (u32x2*)(ws + WS_PB); const size_t n = (size_t)NL * T * 256 / 4;
    const size_t stride = (size_t)nb * 512;
    size_t i = (size_t)bid * 512 + tid;
    for (; i + 3 * stride < n; i += 4 * stride) {
      f32x4 v[4];
#pragma unroll
      for (int u = 0; u < 4; ++u) v[u] = __builtin_nontemporal_load(src + i + u * stride);
#pragma unroll
      for (int u = 0; u < 4; ++u) { u32x2 w; w.x = cvt_pk_bf16(v[u][0], v[u][1]); w.y = cvt_pk_bf16(v[u][2], v[u][3]); dst[i + u * stride] = w; }
    }
    for (; i < n; i += stride) { const f32x4 v = src[i]; u32x2 w; w.x = cvt_pk_bf16(v[0], v[1]); w.y = cvt_pk_bf16(v[2], v[3]); dst[i] = w; } }
  { const int wid = tid >> 6, lane = tid & 63; float* ssq0 = (float*)(ws + WS_SSQ); bf16_t* hb = (bf16_t*)(ws + WS_HB);
    for (int row = bid * 8 + wid; row < T; row += nb * 8) {
      float sq = 0.f;
#pragma unroll
      for (int i = 0; i < 4; ++i) { const size_t off = (size_t)row * D + i * 256 + lane * 4; const f32x4 v = *(const f32x4*)(p.in[0] + off);
        store_bf4(hb + off, v); sq += v[0] * v[0] + v[1] * v[1] + v[2] * v[2] + v[3] * v[3]; }
      sq = wave_sum(sq);
      if (lane < 16) ssq0[(size_t)row * 16 + lane] = lane == 0 ? sq : 0.f;
    } }
  { constexpr int NT_KIND[10] = {1408, 704, 704, 32, 32, 256, 1408, 704, 256, 64};
    constexpr int PER_LAYER = 5568;
    const int wid = tid >> 6, lane = tid & 63;
    for (int t = bid * 8 + wid; t < NL * PER_LAYER; t += nb * 8) {
      const int layer = t / PER_LAYER; int r = t % PER_LAYER, kind = 0;
#pragma unroll
      for (int k = 0; k < 9; ++k) { if (kind == k && r >= NT_KIND[k]) { r -= NT_KIND[k]; kind = k + 1; } }
      WDesc d; get_wdesc(p, layer, kind, d);
      const int nkt = d.Kpad / 64, n0 = (r / nkt) * 64, k0 = (r % nkt) * 64;
      const int sc = wsrc_col(d.mode, n0 + lane, d.Nsrc);
      const bool live = sc >= 0 && k0 < d.K;
      const float* sp = d.src + (size_t)k0 * d.Nsrc + (sc >= 0 ? sc : 0);
      bf16_t* dp = d.dst + (size_t)(n0 + lane) * d.Kpad + k0;
      float v[64];
#pragma unroll
      for (int e = 0; e < 64; ++e) v[e] = live ? __builtin_nontemporal_load(sp + (size_t)e * d.Nsrc) : 0.f;
      if (d.gain && live) {
#pragma unroll
        for (int e = 0; e < 64; ++e) v[e] *= d.gain[k0 + e];
      }
#pragma unroll
      for (int kc = 0; kc < 8; ++kc) {
        u32x4 w; w.x = cvt_pk_bf16(v[kc * 8 + 0], v[kc * 8 + 1]); w.y = cvt_pk_bf16(v[kc * 8 + 2], v[kc * 8 + 3]); w.z = cvt_pk_bf16(v[kc * 8 + 4], v[kc * 8 + 5]); w.w = cvt_pk_bf16(v[kc * 8 + 6], v[kc * 8 + 7]);
        *(u32x4*)(dp + kc * 8) = w;
      }
    }
  }
}

__device__ __forceinline__ void rope_sweep(const Params& p) {
  unsigned char* ws = opq(p.ws); const bf16_t* ckv = (const bf16_t*)(ws + WS_CKV); bf16_t* km = (bf16_t*)(ws + WS_KM);
  const float* cosm = (const float*)(ws + WS_ROPE) + T * 16; const float* sinm = cosm + T * 16;
  for (int tok = blockIdx.x * 512 + opaque_tid(); tok < T; tok += gridDim.x * 512) {
    const bf16_t* src = ckv + (size_t)tok * 256 + 128;
    float x[32];
#pragma unroll
    for (int q = 0; q < 4; ++q) { const u32x4 w = *(const u32x4*)(src + q * 8); const unsigned* wp = (const unsigned*)&w;
#pragma unroll
      for (int j = 0; j < 4; ++j) { x[q * 8 + 2 * j] = bf2f(wp[j] & 0xffffu); x[q * 8 + 2 * j + 1] = __uint_as_float(wp[j] & 0xffff0000u); } }
    unsigned o[16];
#pragma unroll
    for (int j = 0; j < 16; j += 2) {
      const float c0 = cosm[tok * 16 + j], s0 = sinm[tok * 16 + j], c1 = cosm[tok * 16 + j + 1], s1 = sinm[tok * 16 + j + 1];
      o[j / 2] = cvt_pk_bf16(x[j] * c0 - x[j + 16] * s0, x[j + 1] * c1 - x[j + 17] * s1);
      o[8 + j / 2] = cvt_pk_bf16(x[j + 16] * c0 + x[j] * s0, x[j + 17] * c1 + x[j + 1] * s1);
    }
#pragma unroll
    for (int h = 0; h < 4; ++h) { u32x4* dst = (u32x4*)(km + (size_t)tok * 384 + h * 96 + 64);
#pragma unroll
      for (int q = 0; q < 4; ++q) { u32x4 w; w.x = o[q * 4]; w.y = o[q * 4 + 1]; w.z = o[q * 4 + 2]; w.w = o[q * 4 + 3]; dst[q] = w; } }
  }
}

__device__ __forceinline__ void final_norm(const Params& p) {
  const int tid = opaque_tid(), wid = tid >> 6, lane = tid & 63; const float* ssq = (const float*)(p.ws + WS_SSQ); const float* gain = p.in[24];
  for (int row = blockIdx.x * 8 + wid; row < T; row += gridDim.x * 8) {
    const float rs = rsqrtf(sum16(ssq + (size_t)row * 16) * (1.0f / D) + EPS);
#pragma unroll
    for (int i = 0; i < 4; ++i) { const size_t off = (size_t)row * D + i * 256 + lane * 4; f32x4 v = load_bf4((const bf16_t*)(p.ws + WS_HB2) + off); const f32x4 g = *(const f32x4*)(gain + i * 256 + lane * 4);
      v = v * rs * g;
      *(f32x4*)(p.out + off) = v; }
  }
}

constexpr int LDS_BYTES = pg8::STAGE_BYTES + 16;

__global__ void __launch_bounds__(512) mk_forward(Params p) {
  extern __shared__ __attribute__((aligned(16))) unsigned char smem[];
  LAS unsigned char* lds = (LAS unsigned char*)smem;
  cg::grid_group grid = cg::this_grid();
  if (threadIdx.x == 0) { *(LAS u32x4*)(lds + pg8::STAGE_BYTES) = (u32x4){0u, 0u, 0u, 0u}; }
  __syncthreads();
  const XcdBarrier xbar = xcd_barrier_post((unsigned*)(p.ws + WS_BAR), (volatile LAS unsigned*)(lds + pg8::STAGE_BYTES));
  unsigned char* ws = p.ws;
  const int G = gridDim.x;

  prologue(p, lds);
  grid.sync();
  { volatile LAS unsigned* st = (volatile LAS unsigned*)(lds + pg8::STAGE_BYTES);
    if (threadIdx.x == 0) {
      unsigned* bar = (unsigned*)(p.ws + WS_BAR); unsigned nx = 0, idx = 0, per = 0; bool ok = true;
      for (unsigned j = 0; j < 16; ++j) { const unsigned c = xb_ld(&bar[XB_XCNT(j)]); if (c) { if (j < xbar.x) ++idx; ++nx; if (per == 0) per = c; else if (c != per) ok = false; } }
      ok = ok && nx == 8u && per * nx == (unsigned)G && st[2] < per;
      st[3] = ok ? (0x80000000u | (st[2] * nx + idx)) : blockIdx.x;
    }
    __syncthreads(); }
  const unsigned vbw = ((volatile LAS unsigned*)(lds + pg8::STAGE_BYTES))[3];
  const int bid0 = __builtin_amdgcn_readfirstlane((int)(vbw & 0x7fffffffu));
  const bool local_ok = __builtin_amdgcn_readfirstlane((int)(vbw >> 31)) != 0;
#define SEAM_LOCAL() do { if (local_ok) xcd_barrier_local(xbar); else xcd_barrier(xbar); } while (0)

  for (int layer = 0; layer < NL; ++layer) {
    int bid = bid0; asm volatile("" : "+s"(bid));
    pg8::StaticOrder so;
    const size_t HB1 = layer ? WS_HB2 : WS_HB;
    { unsigned char* w = opq(ws); unsigned char* wl = w + WS_W + (size_t)layer * SZ_WL; float* sA = (float*)(w + WS_SSQ); float* sB = sA + (size_t)T * 16;
      so.init(T, GU, G, bid); pg8::gemm_phase<true>(lds, pg8::Gemm{(const bf16_t*)(w + HB1), (const bf16_t*)(wl + WO_GU1), T, GU, D}, so, EpiGU{sA, (bf16_t*)(w + WS_ACT)}); }
    SEAM_LOCAL();
    { unsigned char* w = opq(ws); unsigned char* wl = w + WS_W + (size_t)layer * SZ_WL; float* sA = (float*)(w + WS_SSQ); float* sB = sA + (size_t)T * 16;
      so.init(T, D, G, bid); pg8::gemm_phase<true>(lds, pg8::Gemm{(const bf16_t*)(w + WS_ACT), (const bf16_t*)(wl + WO_D1), T, D, FF}, so, EpiResP{layer ? (const float*)nullptr : opq(p.in[0]), (const bf16_t*)(w + WS_HB2), (bf16_t*)(w + WS_HB), sB, 0.5f}); }
    xcd_barrier(xbar);
    { unsigned char* w = opq(ws); unsigned char* wl = w + WS_W + (size_t)layer * SZ_WL; float* sA = (float*)(w + WS_SSQ); float* sB = sA + (size_t)T * 16;
      so.init(T, NQ, G, bid); pg8::gemm_phase(lds, pg8::Gemm{(const bf16_t*)(w + WS_HB), (const bf16_t*)(wl + WO_IN), T, NQ, D}, so,
        EpiWin{sB, (bf16_t*)(w + WS_QKV), (bf16_t*)(w + WS_CQ), (bf16_t*)(w + WS_CKV), (bf16_t*)(w + WS_VTSB), (bf16_t*)(w + WS_VTDF),
               (float*)(w + WS_SSQQ), (float*)(w + WS_SSQKV), (const float*)(w + WS_ROPE), (const float*)(w + WS_ROPE) + T * 8}); }
    xcd_barrier(xbar);
    { unsigned char* w = opq(ws); unsigned char* wl = w + WS_W + (size_t)layer * SZ_WL;
      const float* cosm = (const float*)(w + WS_ROPE) + T * 16; const float* sinm = cosm + T * 16;
      so.init(T, 512, G, bid < G / 2 ? bid : -1); pg8::gemm_phase(lds, pg8::Gemm{(const bf16_t*)(w + WS_CQ), (const bf16_t*)(wl + WO_UPQ), T, 512, 256}, so,
        EpiUpQ{(float*)(w + WS_SSQQ), (bf16_t*)(w + WS_QM), cosm, sinm});
      so.init(T, 512, G - G / 2, bid >= G / 2 ? bid - G / 2 : -1); pg8::gemm_phase(lds, pg8::Gemm{(const bf16_t*)(w + WS_CKV), (const bf16_t*)(wl + WO_UPKV), T, 512, 256}, so,
        EpiUpKV{(float*)(w + WS_SSQKV), (bf16_t*)(w + WS_KM), (bf16_t*)(w + WS_VTML)});
      rope_sweep(p); }
    { asm volatile("s_waitcnt vmcnt(0)" ::: "memory"); __syncthreads();
      if (threadIdx.x == 0) { __builtin_amdgcn_fence(__ATOMIC_RELEASE, "agent"); asm volatile("s_waitcnt vmcnt(0)" ::: "memory");
        __hip_atomic_fetch_add((unsigned*)(opq(ws) + WS_CTR) + 16 + layer, 1u, __ATOMIC_RELAXED, __HIP_MEMORY_SCOPE_AGENT); } }
    attn_phase(p, layer, lds, (int*)(opq(ws) + WS_CTR) + layer, (unsigned*)(opq(ws) + WS_CTR) + 16 + layer);
    xcd_barrier(xbar);
    { unsigned char* w = opq(ws); unsigned char* wl = w + WS_W + (size_t)layer * SZ_WL; float* sA = (float*)(w + WS_SSQ); float* sB = sA + (size_t)T * 16;
      so.init(T, D, G, bid); pg8::gemm_phase<true>(lds, pg8::Gemm{(const bf16_t*)(w + WS_MIX), (const bf16_t*)(wl + WO_OUT), T, D, D}, so, EpiResP{(const float*)nullptr, (const bf16_t*)(w + WS_HB), (bf16_t*)(w + WS_HB), sA, 1.0f}); }
    SEAM_LOCAL();
    { unsigned char* w = opq(ws); unsigned char* wl = w + WS_W + (size_t)layer * SZ_WL; float* sA = (float*)(w + WS_SSQ); float* sB = sA + (size_t)T * 16;
      so.init(T, GU, G, bid); pg8::gemm_phase<true>(lds, pg8::Gemm{(const bf16_t*)(w + WS_HB), (const bf16_t*)(wl + WO_GU2), T, GU, D}, so, EpiGU{sA, (bf16_t*)(w + WS_ACT)});
      so.init(T, D, G - G / 2, bid >= G / 2 ? bid - G / 2 : -1); pg8::gemm_phase(lds, pg8::Gemm{(const bf16_t*)(w + WS_PB) + (size_t)layer * T * 256, (const bf16_t*)(wl + WO_PJ), T, D, 256}, so, EpiProj{(bf16_t*)(w + WS_MIX)}); }
    SEAM_LOCAL();
    { unsigned char* w = opq(ws); unsigned char* wl = w + WS_W + (size_t)layer * SZ_WL; float* sA = (float*)(w + WS_SSQ); float* sB = sA + (size_t)T * 16;
      so.init(T, D, G, bid); pg8::gemm_phase<true>(lds, pg8::Gemm{(const bf16_t*)(w + WS_ACT), (const bf16_t*)(wl + WO_D2), T, D, FF}, so, EpiResP{(const float*)nullptr, (const bf16_t*)(w + WS_HB), (bf16_t*)(w + WS_HB), sB, 0.5f}); }
    SEAM_LOCAL();
    { unsigned char* w = opq(ws); unsigned char* wl = w + WS_W + (size_t)layer * SZ_WL; float* sA = (float*)(w + WS_SSQ); float* sB = sA + (size_t)T * 16;
      so.init(T, D, G, bid); pg8::gemm_phase<true>(lds, pg8::Gemm{(const bf16_t*)(w + WS_HB), (const bf16_t*)(wl + WO_GATE), T, D, D}, so, EpiPleP{sB, (const bf16_t*)(w + WS_MIX), (const bf16_t*)(w + WS_HB), (bf16_t*)(w + WS_HB2), sA}); }
    if (layer + 1 < NL) SEAM_LOCAL(); else xcd_barrier(xbar);
  }
  final_norm(p);
}

extern "C" void kernel_launch(void* const* d_in, const int* in_sizes, int n_in, void* d_out, int out_size, void* d_ws, size_t ws_size, hipStream_t stream) {
  static int grid = 0;
  if (grid == 0) {
    int dev = 0, cus = 0, per_cu = 0;
    if (n_in != 25 || out_size != T * D || ws_size < WS_END) { fprintf(stderr, "kernel_launch: unexpected shapes (n_in %d out %d ws %zu need %zu)\n", n_in, out_size, ws_size, (size_t)WS_END); grid = -1; return; }
    (void)hipGetDevice(&dev);
    (void)hipDeviceGetAttribute(&cus, hipDeviceAttributeMultiprocessorCount, dev);
    if (hipFuncSetAttribute((const void*)mk_forward, hipFuncAttributeMaxDynamicSharedMemorySize, LDS_BYTES) != hipSuccess) { fprintf(stderr, "kernel_launch: hipFuncSetAttribute failed\n"); grid = -1; return; }
    (void)hipOccupancyMaxActiveBlocksPerMultiprocessor(&per_cu, (const void*)mk_forward, 512, LDS_BYTES);
    (void)hipGetLastError();
    if (per_cu < 1) fprintf(stderr, "kernel_launch: occupancy query says %d blocks per CU\n", per_cu);
    grid = cus;
  }
  if (grid < 0) return;
  Params p{};
  for (int i = 0; i < 25; ++i) p.in[i] = (const float*)d_in[i];
  p.out = (float*)d_out; p.ws = (unsigned char*)d_ws;
  if (hipMemsetAsync((unsigned char*)d_ws + WS_BAR, 0, XCD_BAR_WORDS * 4, stream) != hipSuccess) { fprintf(stderr, "kernel_launch: memset of the barrier words failed\n"); return; }
  void* args[] = {&p};
  hipError_t e = hipLaunchCooperativeKernel((const void*)mk_forward, dim3(grid), dim3(512), args, LDS_BYTES, stream);
  if (e != hipSuccess) fprintf(stderr, "kernel_launch: cooperative launch failed: %s (grid %d)\n", hipGetErrorString(e), grid);
}
```

```cpp
#include <hip/hip_runtime.h>
#include <hip/hip_cooperative_groups.h>
#include <cstdio>
namespace cg = cooperative_groups;

#define LAS __attribute__((address_space(3)))
typedef unsigned short bf16_t;
typedef short bf16x8 __attribute__((ext_vector_type(8)));
typedef float f32x4 __attribute__((ext_vector_type(4)));
typedef float f32x16 __attribute__((ext_vector_type(16)));
typedef unsigned u32x4 __attribute__((ext_vector_type(4)));
typedef unsigned u32x2 __attribute__((ext_vector_type(2)));

constexpr int T = 16384, SEQ = 4096, D = 1024, FF = 2816, GU = 5632, NQ = 2816, QW = 2304, NL = 4;
constexpr float EPS = 1e-6f;
constexpr float LOG2E = 1.4426950408889634f, LN2 = 0.6931471805599453f;

constexpr size_t al(size_t x) { return (x + 255) & ~(size_t)255; }
constexpr size_t SZ_WGU = (size_t)GU * D * 2, SZ_WD = (size_t)D * FF * 2, SZ_WIN = (size_t)NQ * D * 2, SZ_WUP = (size_t)512 * 256 * 2,
                 SZ_WSQ = (size_t)D * D * 2, SZ_WPJ = (size_t)D * 256 * 2;
constexpr size_t WO_GU1 = 0, WO_D1 = WO_GU1 + SZ_WGU, WO_IN = WO_D1 + SZ_WD, WO_UPQ = WO_IN + SZ_WIN, WO_UPKV = WO_UPQ + SZ_WUP,
                 WO_OUT = WO_UPKV + SZ_WUP, WO_GU2 = WO_OUT + SZ_WSQ, WO_D2 = WO_GU2 + SZ_WGU, WO_GATE = WO_D2 + SZ_WD, WO_PJ = WO_GATE + SZ_WSQ,
                 SZ_WL = WO_PJ + SZ_WPJ;
constexpr size_t WS_W = 0;
constexpr size_t WS_HB = al(WS_W + NL * SZ_WL);
constexpr size_t WS_ACT = al(WS_HB + (size_t)T * D * 2);
constexpr size_t WS_QKV = WS_ACT;
constexpr size_t WS_CQ = al(WS_QKV + (size_t)T * QW * 2);
constexpr size_t WS_CKV = al(WS_CQ + (size_t)T * 256 * 2);
constexpr size_t WS_ACT_END = al(WS_CKV + (size_t)T * 256 * 2) > al(WS_ACT + (size_t)T * FF * 2) ? al(WS_CKV + (size_t)T * 256 * 2) : al(WS_ACT + (size_t)T * FF * 2);
constexpr size_t WS_MIX = WS_ACT_END;
constexpr size_t WS_PB = al(WS_MIX + (size_t)T * D * 2);
constexpr size_t WS_VTSB = al(WS_PB + (size_t)NL * T * 256 * 2);
constexpr size_t WS_VTDF = al(WS_VTSB + (size_t)16 * 64 * SEQ * 2);
constexpr size_t WS_VTML = al(WS_VTDF + (size_t)16 * 128 * SEQ * 2);
constexpr size_t WS_QM = al(WS_VTML + (size_t)16 * 64 * SEQ * 2);
constexpr size_t WS_KM = al(WS_QM + (size_t)T * 384 * 2);
constexpr size_t WS_SSQ = al(WS_KM + (size_t)T * 384 * 2);
constexpr size_t WS_SSQQ = WS_SSQ + (size_t)2 * T * 16 * 4;
constexpr size_t WS_SSQKV = WS_SSQQ + (size_t)T * 4 * 4;
constexpr size_t WS_CTR = WS_SSQKV + (size_t)T * 4 * 4;
constexpr size_t WS_BAR = al(WS_CTR + 256);
constexpr size_t WS_ROPE = al(WS_BAR + 5504 * 4);
constexpr size_t WS_STASH = al(WS_ROPE + (size_t)T * 48 * 4);
constexpr size_t WS_END = al(WS_STASH + (size_t)256 * 16 * 512 * 16);
constexpr size_t WS_HB2 = WS_VTML;
static_assert(WS_HB2 + (size_t)T * D * 2 <= WS_SSQ, "hb2 alias overflows");

struct Params { const float* in[25]; float* out; unsigned char* ws; };

typedef __bf16 bf16x2_t __attribute__((ext_vector_type(2)));
typedef float f32x2_t __attribute__((ext_vector_type(2)));
__device__ __forceinline__ unsigned cvt_pk_bf16(float lo, float hi) { f32x2_t v = {lo, hi}; bf16x2_t b = __builtin_convertvector(v, bf16x2_t); return __builtin_bit_cast(unsigned, b); }
__device__ __forceinline__ bf16_t f2bf(float f) { unsigned u = __float_as_uint(f); u += 0x7FFFu + ((u >> 16) & 1u); return (bf16_t)(u >> 16); }
__device__ __forceinline__ float bf2f(unsigned v) { return __uint_as_float(v << 16); }
__device__ __forceinline__ float fexp2(float x) { return __builtin_amdgcn_exp2f(x); }
__device__ __forceinline__ float flog2(float x) { return __builtin_amdgcn_logf(x); }
__device__ __forceinline__ float frcp(float x) { return __builtin_amdgcn_rcpf(x); }
__device__ __forceinline__ int opaque_tid() { int t = threadIdx.x; asm volatile("" : "+v"(t)); return t; }
template <class P> __device__ __forceinline__ P* opq(P* p) { unsigned z; asm volatile("s_mov_b32 %0, 0" : "=s"(z)); return (P*)((unsigned char*)p + z); }
__device__ __forceinline__ float sum16(const float* p) { const f32x4 a = *(const f32x4*)p, b = *(const f32x4*)(p + 4), c = *(const f32x4*)(p + 8), d = *(const f32x4*)(p + 12);
  return (((a[0] + a[1]) + (a[2] + a[3])) + ((b[0] + b[1]) + (b[2] + b[3]))) + (((c[0] + c[1]) + (c[2] + c[3])) + ((d[0] + d[1]) + (d[2] + d[3]))); }
__device__ __forceinline__ float sum4(const float* p) { const f32x4 a = *(const f32x4*)p; return (a[0] + a[1]) + (a[2] + a[3]); }
__device__ __forceinline__ float wave_sum(float v) {
  v += __shfl_xor(v, 32); v += __shfl_xor(v, 16); v += __shfl_xor(v, 8); v += __shfl_xor(v, 4); v += __shfl_xor(v, 2); v += __shfl_xor(v, 1); return v;
}


#define XB_TMO      128
#define XB_XCNT(j)  (256  + 64 * (j))
#define XB_XSUB(j)  (1280 + 64 * (j))
#define XB_XGEN(j)  (2304 + 64 * (j))
#define XB_TOP      3328
#define XB_TOPGEN   3392
#define XB_LSUB(j)  (3456 + 64 * (j))
#define XB_LGEN(j)  (4480 + 64 * (j))
#define XCD_BAR_WORDS 5504
#define XB_SPIN_CAP (1u << 18)
__device__ __forceinline__ unsigned xb_ld(unsigned* p)              { return __hip_atomic_load(p, __ATOMIC_RELAXED, __HIP_MEMORY_SCOPE_AGENT); }
__device__ __forceinline__ unsigned xb_add(unsigned* p, unsigned v) { return __hip_atomic_fetch_add(p, v, __ATOMIC_RELAXED, __HIP_MEMORY_SCOPE_AGENT); }
__device__ __forceinline__ unsigned xb_xcc_id() { return (unsigned)__builtin_amdgcn_s_getreg((3 << 11) | 20) & 0xFu; }
#define XB_SPIN(cond, bar) do { unsigned _sp = 0; while (cond) { __builtin_amdgcn_s_sleep(1); \
    if ((++_sp & 255u) == 0u) { if (xb_ld(&(bar)[XB_TMO])) break; if (_sp > XB_SPIN_CAP) { atomicAdd(&(bar)[XB_TMO], 1u); break; } } } } while (0)
struct XcdBarrier { unsigned* bar; unsigned x; volatile LAS unsigned* st; };
__device__ __forceinline__ XcdBarrier xcd_barrier_post(unsigned* bar, volatile LAS unsigned* st) {
  XcdBarrier b; b.bar = bar; b.x = xb_xcc_id(); b.st = st;
  if (threadIdx.x == 0) st[2] = xb_add(&bar[XB_XCNT(b.x)], 1u);
  return b;
}
__device__ __forceinline__ void xcd_barrier_complete(unsigned* bar, unsigned x, unsigned& nloc, unsigned& nx) {
  const unsigned G = gridDim.x * gridDim.y * gridDim.z;
  unsigned sum, cnt, mine, sp = 0u;
  for (;;) {
    sum = 0u; cnt = 0u; mine = 0u;
#pragma unroll
    for (unsigned j = 0; j < 16; ++j) { const unsigned c = xb_ld(&bar[XB_XCNT(j)]); sum += c; cnt += (c > 0u) ? 1u : 0u; mine = (j == x) ? c : mine; }
    if (sum == G) break;
    __builtin_amdgcn_s_sleep(1);
    if ((++sp & 255u) == 0u) { if (xb_ld(&bar[XB_TMO])) break; if (sp > XB_SPIN_CAP) { atomicAdd(&bar[XB_TMO], 1u); break; } }
  }
  nloc = mine > 0u ? mine : 1u; nx = cnt > 0u ? cnt : 1u;
}
__device__ __forceinline__ void xcd_barrier(const XcdBarrier& b) {
  asm volatile("s_waitcnt vmcnt(0)" ::: "memory");
  __syncthreads();
  if (threadIdx.x == 0) {
    unsigned* bar = b.bar;
    __builtin_amdgcn_s_waitcnt(0);
    unsigned nloc = b.st[0], nx = b.st[1];
    if (nloc == 0u) { xcd_barrier_complete(bar, b.x, nloc, nx); b.st[0] = nloc; b.st[1] = nx; }
    const unsigned old = xb_add(&bar[XB_XSUB(b.x)], 1u);
    const unsigned gen = old / nloc;
    if (old + 1u == (gen + 1u) * nloc) {
      __builtin_amdgcn_fence(__ATOMIC_RELEASE, "agent");
      asm volatile("s_waitcnt vmcnt(0)" ::: "memory");
      const unsigned og = xb_add(&bar[XB_TOP], 1u);
      const unsigned tg = og / nx;
      if (og + 1u == (tg + 1u) * nx) xb_add(&bar[XB_TOPGEN], 1u);
      else XB_SPIN(xb_ld(&bar[XB_TOPGEN]) == tg, bar);
      __builtin_amdgcn_fence(__ATOMIC_ACQUIRE, "agent");
      xb_add(&bar[XB_XGEN(b.x)], 1u);
      asm volatile("s_waitcnt vmcnt(0)" ::: "memory");
    } else {
      XB_SPIN(xb_ld(&bar[XB_XGEN(b.x)]) == gen, bar);
      __builtin_amdgcn_fence(__ATOMIC_ACQUIRE, "agent");
      asm volatile("s_waitcnt vmcnt(0)" ::: "memory");
    }
  }
  __syncthreads();
}

__device__ __forceinline__ void xcd_barrier_local(const XcdBarrier& b) {
  asm volatile("s_waitcnt vmcnt(0)" ::: "memory");
  __syncthreads();
  if (threadIdx.x == 0) {
    unsigned* bar = b.bar;
    __builtin_amdgcn_s_waitcnt(0);
    unsigned nloc = b.st[0], nx = b.st[1];
    if (nloc == 0u) { xcd_barrier_complete(bar, b.x, nloc, nx); b.st[0] = nloc; b.st[1] = nx; }
    const unsigned old = xb_add(&bar[XB_LSUB(b.x)], 1u);
    const unsigned gen = old / nloc;
    if (old + 1u == (gen + 1u) * nloc) xb_add(&bar[XB_LGEN(b.x)], 1u);
    else XB_SPIN(xb_ld(&bar[XB_LGEN(b.x)]) == gen, bar);
    __builtin_amdgcn_fence(__ATOMIC_ACQUIRE, "agent");
    asm volatile("s_waitcnt vmcnt(0)" ::: "memory");
  }
  __syncthreads();
}

namespace pg8 {
constexpr int BM = 256, BK = 64, HALF = 128, HTB = HALF * BK * 2, STAGE_BYTES = 8 * HTB, NXCD = 8, WGM = 8;
__host__ __device__ __forceinline__ int lds_byte(int r, int c) { const int st = (r >> 4) * 2 + (c >> 5), rr = r & 15, cc = c & 31, ob = rr * 64 + cc * 2; return st * 1024 + (ob ^ (((ob >> 9) & 1) << 5)); }
__host__ __device__ __forceinline__ void stage_rc(int b, int& R, int& C) { const int st = b / 1024, sb = b % 1024, swz = sb ^ (((sb >> 9) & 1) << 5); R = (st >> 1) * 16 + swz / 64; C = (st & 1) * 32 + (swz % 64) / 2; }
struct Unit { int pm, pn; };
struct Gemm { const bf16_t* A; const bf16_t* Bt; int M, N, K; };
__device__ __forceinline__ void map_tile(int L, int nM, int nN, Unit& u) {
  const int nwg = nM * nN; int wgid = L;
  { const int q = nwg / NXCD, r = nwg % NXCD, xcd = wgid % NXCD, off = wgid / NXCD; wgid = (xcd < r ? xcd * (q + 1) : r * (q + 1) + (xcd - r) * q) + off; }
  const int nig = WGM * nN, gid = wgid / nig, fm = gid * WGM, gsz = (nM - fm) < WGM ? (nM - fm) : WGM;
  u.pm = fm + ((wgid % nig) % gsz); u.pn = (wgid % nig) / gsz;
}
struct StaticOrder {
  int nM, nN, nwg, G, c;
  __device__ void init(int M, int N, int G_, int c_) { nM = M / BM; nN = N / BM; nwg = nM * nN; G = G_; c = c_; }
  __device__ bool next(int i, Unit& u) const { const long L = (long)i * G + c; if (L >= nwg || c < 0) return false; map_tile((int)L, nM, nN, u); return true; }
};

__host__ __device__ __forceinline__ int perm32(int rho) { const int n = rho >> 4, i = rho & 15; return 8 * (i >> 2) + 4 * n + (i & 3); }
template <bool PERM = false, class Epi, class Sched>
__device__ __forceinline__ void gemm_phase(LAS unsigned char* lds, const Gemm g, const Sched& S, const Epi& E) {
  const int tid = opaque_tid(), wid = __builtin_amdgcn_readfirstlane(tid >> 6), lane = tid & 63, wr = wid >> 2, wc = wid & 3, fr = lane & 15, fq = lane >> 4;
  const int K = g.K, nt = K / BK;
  unsigned voffA[2], voffB[2];
#pragma unroll
  for (int i = 0; i < 2; ++i) { int R, C; stage_rc(tid * 16 + i * 8192, R, C); const int Rb = PERM ? ((R & ~31) + perm32(R & 31)) : R;
    voffA[i] = (unsigned)(R * K + C) * 2u; voffB[i] = (unsigned)(Rb * K + C) * 2u; }
  const size_t kstep = (size_t)(BK * 2);
  const size_t hstep = (size_t)HALF * K * 2;
  const size_t tstep = 2 * hstep;
  const unsigned ldsw = (unsigned)wid * 1024u;
  const int aoff = lds_byte(wr * 64 + fr, fq * 8), boff = lds_byte(wc * 32 + fr, fq * 8);
#define PG8_SA(b, h) (((b) * 2 + (h)) * HTB)
#define PG8_SB(b, h) ((4 + (b) * 2 + (h)) * HTB)
#define PG8_STAGE(bufoff, gbase, voff) do { _Pragma("unroll") for (int _i = 0; _i < 2; ++_i) \
    __builtin_amdgcn_global_load_lds((const unsigned*)((const char*)(gbase) + (voff)[_i]), (LAS unsigned*)(lds + (bufoff) + ldsw + _i * 8192), 16, 0, 0); } while (0)
#define PG8_LDA(dst, b, h) do { _Pragma("unroll") for (int m = 0; m < 4; ++m) _Pragma("unroll") for (int k = 0; k < 2; ++k) dst[m][k] = *(const LAS bf16x8*)(lds + PG8_SA(b, h) + aoff + m * 2048 + k * 1024); } while (0)
#define PG8_LDB(dst, b, h) do { _Pragma("unroll") for (int n = 0; n < 2; ++n) _Pragma("unroll") for (int k = 0; k < 2; ++k) dst[n][k] = *(const LAS bf16x8*)(lds + PG8_SB(b, h) + boff + n * 2048 + k * 1024); } while (0)
#define PG8_MMA(ai, bj, At, Bt) do { __builtin_amdgcn_s_setprio(1); _Pragma("unroll") for (int m = 0; m < 4; ++m) _Pragma("unroll") for (int n = 0; n < 2; ++n) _Pragma("unroll") for (int k = 0; k < 2; ++k) \
    acc[ai][bj][m][n] = __builtin_amdgcn_mfma_f32_16x16x32_bf16(Bt[n][k], At[m][k], acc[ai][bj][m][n], 0, 0, 0); __builtin_amdgcn_s_setprio(0); } while (0)
#define PG8_WAIT_V(n) asm volatile("s_waitcnt vmcnt(" #n ")" ::: "memory")
#define PG8_WAIT_L(n) asm volatile("s_waitcnt lgkmcnt(" #n ")" ::: "memory")
#define PG8_BAR __builtin_amdgcn_s_barrier()
#define PG8_SCHED __builtin_amdgcn_sched_barrier(0)
  Unit cur, nxt; int ui = 0;
  if (!S.next(0, cur)) return;
  f32x4 acc[2][2][4][2];
#pragma unroll
  for (int a = 0; a < 2; ++a)
#pragma unroll
    for (int b = 0; b < 2; ++b)
#pragma unroll
      for (int m = 0; m < 4; ++m)
#pragma unroll
        for (int n = 0; n < 2; ++n) acc[a][b][m][n] = (f32x4){0.f, 0.f, 0.f, 0.f};
  bf16x8 At[4][2], B0[2][2], B1[2][2];
  const char* cA = (const char*)g.A + (size_t)cur.pm * tstep; const char* cB = (const char*)g.Bt + (size_t)cur.pn * tstep;
  PG8_STAGE(PG8_SB(0, 0), cB, voffB); PG8_STAGE(PG8_SA(0, 0), cA, voffA); PG8_STAGE(PG8_SB(0, 1), cB + hstep, voffB); PG8_STAGE(PG8_SA(0, 1), cA + hstep, voffA);
  if (wr == 1) PG8_BAR;
  PG8_WAIT_V(4); PG8_BAR;
  PG8_STAGE(PG8_SB(1, 0), cB + kstep, voffB); PG8_STAGE(PG8_SA(1, 0), cA + kstep, voffA); PG8_STAGE(PG8_SB(1, 1), cB + hstep + kstep, voffB);
  PG8_WAIT_V(6); PG8_BAR;
  for (;;) {
    const bool has_next = S.next(ui + 1, nxt);
    const char* nA = has_next ? (const char*)g.A + (size_t)nxt.pm * tstep : cA; const char* nB = has_next ? (const char*)g.Bt + (size_t)nxt.pn * tstep : cB;
#pragma unroll 1
    for (int t = 0; t < nt; t += 2) {
      const bool last = (t == nt - 2);
      const char* a1 = cA + (size_t)(t + 1) * kstep;
      const char* a2 = last ? nA : cA + (size_t)(t + 2) * kstep; const char* b2 = last ? nB : cB + (size_t)(t + 2) * kstep;
      const char* a3 = a2 + kstep; const char* b3 = b2 + kstep;
      PG8_LDB(B0, 0, 0); PG8_SCHED; PG8_LDA(At, 0, 0); PG8_STAGE(PG8_SA(1, 1), a1 + hstep, voffA);
      PG8_WAIT_L(8); PG8_BAR; PG8_WAIT_L(0); PG8_MMA(0, 0, At, B0); PG8_BAR; PG8_SCHED;
      PG8_LDB(B1, 0, 1); PG8_STAGE(PG8_SB(0, 0), b2, voffB);
      PG8_BAR; PG8_WAIT_L(0); PG8_MMA(0, 1, At, B1); PG8_BAR;
      PG8_LDA(At, 0, 1); PG8_STAGE(PG8_SA(0, 0), a2, voffA);
      PG8_BAR; PG8_WAIT_L(0); PG8_MMA(1, 0, At, B0); PG8_BAR; PG8_SCHED;
      PG8_STAGE(PG8_SB(0, 1), b2 + hstep, voffB);
      PG8_WAIT_V(6); PG8_BAR; PG8_MMA(1, 1, At, B1); PG8_BAR;
      PG8_LDB(B0, 1, 0); PG8_SCHED; PG8_LDA(At, 1, 0); PG8_STAGE(PG8_SA(0, 1), a2 + hstep, voffA);
      PG8_WAIT_L(8); PG8_BAR; PG8_WAIT_L(0); PG8_MMA(0, 0, At, B0); PG8_BAR; PG8_SCHED;
      PG8_LDB(B1, 1, 1); PG8_STAGE(PG8_SB(1, 0), b3, voffB);
      PG8_BAR; PG8_WAIT_L(0); PG8_MMA(0, 1, At, B1); PG8_BAR;
      PG8_LDA(At, 1, 1); PG8_STAGE(PG8_SA(1, 0), a3, voffA);
      PG8_BAR; PG8_WAIT_L(0); PG8_MMA(1, 0, At, B0); PG8_BAR; PG8_SCHED;
      PG8_STAGE(PG8_SB(1, 1), b3 + hstep, voffB);
      PG8_WAIT_V(6); PG8_BAR; PG8_MMA(1, 1, At, B1); PG8_BAR;
    }
    E(acc, cur, wr, wc, fr, fq);
    if (!has_next) break;
#pragma unroll
    for (int a = 0; a < 2; ++a)
#pragma unroll
      for (int b = 0; b < 2; ++b)
#pragma unroll
        for (int m = 0; m < 4; ++m)
#pragma unroll
          for (int n = 0; n < 2; ++n) acc[a][b][m][n] = (f32x4){0.f, 0.f, 0.f, 0.f};
    cur = nxt; cA = nA; cB = nB; ++ui;
  }
  PG8_WAIT_V(0);
  if (wr == 0) PG8_BAR;
  PG8_BAR;
#undef PG8_SA
#undef PG8_SB
#undef PG8_STAGE
#undef PG8_LDA
#undef PG8_LDB
#undef PG8_MMA
#undef PG8_WAIT_V
#undef PG8_WAIT_L
#undef PG8_BAR
#undef PG8_SCHED
}
}
using pg8::Unit;

#define EPI_ROWS(...) _Pragma("unroll") for (int ai = 0; ai < 2; ++ai) _Pragma("unroll") for (int m = 0; m < 4; ++m) { const int row = u.pm * 256 + ai * 128 + wr * 64 + m * 16 + fr; __VA_ARGS__ }

__device__ __forceinline__ f32x4 load_bf4(const bf16_t* p) { const u32x2 w = *(const u32x2*)p; f32x4 v; v[0] = __uint_as_float(w.x << 16); v[1] = __uint_as_float(w.x & 0xffff0000u); v[2] = __uint_as_float(w.y << 16); v[3] = __uint_as_float(w.y & 0xffff0000u); return v; }
__device__ __forceinline__ void store_bf4(bf16_t* p, f32x4 v) { u32x2 w; w.x = cvt_pk_bf16(v[0], v[1]); w.y = cvt_pk_bf16(v[2], v[3]); *(u32x2*)p = w; }
__device__ __forceinline__ int vt_pos(int w) { return 8 * ((w >> 2) & 1) + 4 * (w >> 3) + (w & 3); }

__device__ __forceinline__ void load_bf8(const bf16_t* p, f32x4& a, f32x4& b) { const u32x4 w = *(const u32x4*)p;
  a[0] = __uint_as_float(w.x << 16); a[1] = __uint_as_float(w.x & 0xffff0000u); a[2] = __uint_as_float(w.y << 16); a[3] = __uint_as_float(w.y & 0xffff0000u);
  b[0] = __uint_as_float(w.z << 16); b[1] = __uint_as_float(w.z & 0xffff0000u); b[2] = __uint_as_float(w.w << 16); b[3] = __uint_as_float(w.w & 0xffff0000u); }
__device__ __forceinline__ void store_bf8(bf16_t* p, const f32x4& a, const f32x4& b) { u32x4 w; w.x = cvt_pk_bf16(a[0], a[1]); w.y = cvt_pk_bf16(a[2], a[3]); w.z = cvt_pk_bf16(b[0], b[1]); w.w = cvt_pk_bf16(b[2], b[3]); *(u32x4*)p = w; }
struct EpiGU {
  const float* ssq; bf16_t* act;
  __device__ __forceinline__ void operator()(const f32x4 (&acc)[2][2][4][2], const Unit& u, int wr, int wc, int fr, int fq) const {
    EPI_ROWS(
      const float rs = rsqrtf(sum16(ssq + (size_t)row * 16) * (1.0f / D) + EPS);
      f32x4 o[2];
      _Pragma("unroll") for (int n = 0; n < 2; ++n) {
        const f32x4 g = acc[ai][0][m][n] * rs, v = acc[ai][1][m][n] * rs;
        _Pragma("unroll") for (int j = 0; j < 4; ++j) o[n][j] = g[j] * frcp(1.0f + fexp2(-g[j] * LOG2E)) * v[j]; }
      store_bf8(act + (size_t)row * FF + u.pn * 128 + wc * 32 + fq * 8, o[0], o[1]);
    )
  }
};
struct EpiRes {
  const float* rin_f; const bf16_t* rin_b; bf16_t* hb; float* ssq_out; float scale;
  __device__ __forceinline__ void operator()(const f32x4 (&acc)[2][2][4][2], const Unit& u, int wr, int wc, int fr, int fq) const {
    EPI_ROWS(
      const size_t off = (size_t)row * D + u.pn * 256 + wc * 32 + fq * 4; float sq = 0.f;
      _Pragma("unroll") for (int bj = 0; bj < 2; ++bj) _Pragma("unroll") for (int n = 0; n < 2; ++n) {
        const size_t o2 = off + bj * 128 + n * 16;
        f32x4 hv = rin_f ? *(const f32x4*)(rin_f + o2) : load_bf4(rin_b + o2); hv += acc[ai][bj][m][n] * scale;
        store_bf4(hb + o2, hv);
        sq += hv[0] * hv[0] + hv[1] * hv[1] + hv[2] * hv[2] + hv[3] * hv[3]; }
      sq += __shfl_xor(sq, 16); sq += __shfl_xor(sq, 32);
      if (fq == 0) ssq_out[(size_t)row * 16 + u.pn * 4 + wc] = sq;
    )
  }
};
struct EpiPle {
  const float* ssq_in; const bf16_t* proj; const bf16_t* rin; bf16_t* hb; float* ssq_out;
  __device__ __forceinline__ void operator()(const f32x4 (&acc)[2][2][4][2], const Unit& u, int wr, int wc, int fr, int fq) const {
    EPI_ROWS(
      const float rs = rsqrtf(sum16(ssq_in + (size_t)row * 16) * (1.0f / D) + EPS);
      const size_t off = (size_t)row * D + u.pn * 256 + wc * 32 + fq * 4; float sq = 0.f;
      _Pragma("unroll") for (int bj = 0; bj < 2; ++bj) _Pragma("unroll") for (int n = 0; n < 2; ++n) {
        const size_t o2 = off + bj * 128 + n * 16;
        f32x4 hv = load_bf4(rin + o2); const f32x4 pr = load_bf4(proj + o2);
        _Pragma("unroll") for (int j = 0; j < 4; ++j) { const float gt = frcp(1.0f + fexp2(-acc[ai][bj][m][n][j] * rs * LOG2E)); hv[j] += pr[j] * gt; }
        store_bf4(hb + o2, hv);
        sq += hv[0] * hv[0] + hv[1] * hv[1] + hv[2] * hv[2] + hv[3] * hv[3]; }
      sq += __shfl_xor(sq, 16); sq += __shfl_xor(sq, 32);
      if (fq == 0) ssq_out[(size_t)row * 16 + u.pn * 4 + wc] = sq;
    )
  }
};
struct EpiResP {
  const float* rin_f; const bf16_t* rin_b; bf16_t* hb; float* ssq_out; float scale;
  __device__ __forceinline__ void operator()(const f32x4 (&acc)[2][2][4][2], const Unit& u, int wr, int wc, int fr, int fq) const {
    EPI_ROWS(
      const size_t off = (size_t)row * D + u.pn * 256 + wc * 32 + fq * 8; float sq = 0.f;
      _Pragma("unroll") for (int bj = 0; bj < 2; ++bj) {
        const size_t o2 = off + bj * 128; f32x4 h0; f32x4 h1;
        if (rin_f) { h0 = *(const f32x4*)(rin_f + o2); h1 = *(const f32x4*)(rin_f + o2 + 4); } else load_bf8(rin_b + o2, h0, h1);
        h0 += acc[ai][bj][m][0] * scale; h1 += acc[ai][bj][m][1] * scale;
        store_bf8(hb + o2, h0, h1);
        sq += (h0[0] * h0[0] + h0[1] * h0[1] + h0[2] * h0[2] + h0[3] * h0[3]) + (h1[0] * h1[0] + h1[1] * h1[1] + h1[2] * h1[2] + h1[3] * h1[3]); }
      sq += __shfl_xor(sq, 16); sq += __shfl_xor(sq, 32);
      if (fq == 0) ssq_out[(size_t)row * 16 + u.pn * 4 + wc] = sq;
    )
  }
};
struct EpiPleP {
  const float* ssq_in; const bf16_t* proj; const bf16_t* rin; bf16_t* hb; float* ssq_out;
  __device__ __forceinline__ void operator()(const f32x4 (&acc)[2][2][4][2], const Unit& u, int wr, int wc, int fr, int fq) const {
    EPI_ROWS(
      const float rs = rsqrtf(sum16(ssq_in + (size_t)row * 16) * (1.0f / D) + EPS);
      const size_t off = (size_t)row * D + u.pn * 256 + wc * 32 + fq * 8; float sq = 0.f;
      _Pragma("unroll") for (int bj = 0; bj < 2; ++bj) {
        const size_t o2 = off + bj * 128; f32x4 h0; f32x4 h1; f32x4 p0; f32x4 p1;
        load_bf8(rin + o2, h0, h1); load_bf8(proj + o2, p0, p1);
        _Pragma("unroll") for (int j = 0; j < 4; ++j) {
          h0[j] += p0[j] * frcp(1.0f + fexp2(-acc[ai][bj][m][0][j] * rs * LOG2E));
          h1[j] += p1[j] * frcp(1.0f + fexp2(-acc[ai][bj][m][1][j] * rs * LOG2E)); }
        store_bf8(hb + o2, h0, h1);
        sq += (h0[0] * h0[0] + h0[1] * h0[1] + h0[2] * h0[2] + h0[3] * h0[3]) + (h1[0] * h1[0] + h1[1] * h1[1] + h1[2] * h1[2] + h1[3] * h1[3]); }
      sq += __shfl_xor(sq, 16); sq += __shfl_xor(sq, 32);
      if (fq == 0) ssq_out[(size_t)row * 16 + u.pn * 4 + wc] = sq;
    )
  }
};
struct EpiProj {
  bf16_t* proj;
  __device__ __forceinline__ void operator()(const f32x4 (&acc)[2][2][4][2], const Unit& u, int wr, int wc, int fr, int fq) const {
    EPI_ROWS(
      const size_t off = (size_t)row * D + u.pn * 256 + wc * 32 + fq * 4;
      _Pragma("unroll") for (int bj = 0; bj < 2; ++bj) _Pragma("unroll") for (int n = 0; n < 2; ++n) store_bf4(proj + off + bj * 128 + n * 16, acc[ai][bj][m][n]);
    )
  }
};
struct EpiWin {
  const float* ssq_in; bf16_t* qkv; bf16_t* cq; bf16_t* ckv; bf16_t* vtsb; bf16_t* vtdf; float* ssqq; float* ssqkv; const float* cosd; const float* sind;
  __device__ __forceinline__ void operator()(const f32x4 (&acc)[2][2][4][2], const Unit& u, int wr, int wc, int fr, int fq) const {
    const int pn = u.pn;
    EPI_ROWS(
      const float rs = rsqrtf(sum16(ssq_in + (size_t)row * 16) * (1.0f / D) + EPS);
      if (pn == 2 || pn == 7 || pn == 8) {
        const int b = row >> 12, s = row & 4095, pos = (s & ~15) + vt_pos(s & 15);
        _Pragma("unroll") for (int bj = 0; bj < 2; ++bj) _Pragma("unroll") for (int n = 0; n < 2; ++n) {
          const int c = pn * 256 + bj * 128 + wc * 32 + n * 16 + fq * 4; const f32x4 v = acc[ai][bj][m][n] * rs;
          bf16_t* base;
          if (pn == 2) { const int cc = c - 512; base = vtsb + ((size_t)((b * 4 + (cc >> 6)) * 64 + (cc & 63))) * SEQ + pos; }
          else { const int cc = c - 1792; base = vtdf + ((size_t)((b * 4 + (cc >> 7)) * 128 + (cc & 127))) * SEQ + pos; }
          _Pragma("unroll") for (int j = 0; j < 4; ++j) base[(size_t)j * SEQ] = f2bf(v[j]);
        }
      } else if (pn >= 9) {
        bf16_t* dst = (pn == 9 ? cq : ckv) + (size_t)row * 256 + wc * 32 + fq * 4; float sq = 0.f;
        _Pragma("unroll") for (int bj = 0; bj < 2; ++bj) _Pragma("unroll") for (int n = 0; n < 2; ++n) {
          const f32x4 v = acc[ai][bj][m][n] * rs; store_bf4(dst + bj * 128 + n * 16, v);
          if (pn == 9 || bj == 0) sq += v[0] * v[0] + v[1] * v[1] + v[2] * v[2] + v[3] * v[3]; }
        sq += __shfl_xor(sq, 16); sq += __shfl_xor(sq, 32);
        if (fq == 0) (pn == 9 ? ssqq : ssqkv)[(size_t)row * 4 + wc] = sq;
      } else {
        bf16_t* dst = qkv + (size_t)row * QW + pn * 256 + wc * 32 + fq * 4;
        const bool rot = pn >= 3 && pn <= 6 && (wc & 1) == 0;
        f32x4 cs4 = {1.f, 1.f, 1.f, 1.f}, sn4 = {0.f, 0.f, 0.f, 0.f};
        if (rot) { cs4 = *(const f32x4*)(cosd + (size_t)row * 8 + (fq & 1) * 4); sn4 = *(const f32x4*)(sind + (size_t)row * 8 + (fq & 1) * 4); if (fq < 2) sn4 = -sn4; }
        _Pragma("unroll") for (int bj = 0; bj < 2; ++bj) _Pragma("unroll") for (int n = 0; n < 2; ++n) {
          f32x4 v = acc[ai][bj][m][n] * rs;
          if (n == 0 && rot) { f32x4 pr; _Pragma("unroll") for (int j = 0; j < 4; ++j) pr[j] = __shfl_xor(v[j], 32); v = v * cs4 + pr * sn4; }
          store_bf4(dst + bj * 128 + n * 16, v);
        }
      }
    )
  }
};
struct EpiUpQ {
  const float* ssqq; bf16_t* qm; const float* cosm; const float* sinm;
  __device__ __forceinline__ void operator()(const f32x4 (&acc)[2][2][4][2], const Unit& u, int wr, int wc, int fr, int fq) const {
    EPI_ROWS(
      const float rs = rsqrtf(sum4(ssqq + (size_t)row * 4) * (1.0f / 256) + EPS);
      _Pragma("unroll") for (int bj = 0; bj < 2; ++bj) {
        const int G = u.pn * 8 + bj * 4 + wc;
        if (G < 12) {
          bf16_t* dst = qm + (size_t)row * 384 + G * 32 + fq * 4;
          f32x4 x1 = acc[ai][bj][m][0] * rs, x2 = acc[ai][bj][m][1] * rs;
          if (G % 3 == 2) {
            const f32x4 c = *(const f32x4*)(cosm + (size_t)row * 16 + fq * 4), s = *(const f32x4*)(sinm + (size_t)row * 16 + fq * 4);
            const f32x4 o1 = x1 * c - x2 * s, o2 = x2 * c + x1 * s; x1 = o1; x2 = o2;
          }
          store_bf4(dst, x1); store_bf4(dst + 16, x2);
        }
      }
    )
  }
};
struct EpiUpKV {
  const float* ssqkv; bf16_t* km; bf16_t* vtml;
  __device__ __forceinline__ void operator()(const f32x4 (&acc)[2][2][4][2], const Unit& u, int wr, int wc, int fr, int fq) const {
    EPI_ROWS(
      const float rs = rsqrtf(sum4(ssqkv + (size_t)row * 4) * (1.0f / 128) + EPS);
      const int b = row >> 12, s = row & 4095, pos = (s & ~15) + vt_pos(s & 15);
      _Pragma("unroll") for (int bj = 0; bj < 2; ++bj) _Pragma("unroll") for (int n = 0; n < 2; ++n) {
        const int c = bj * 128 + wc * 32 + n * 16 + fq * 4; const f32x4 v = acc[ai][bj][m][n] * rs;
        if (u.pn == 0) store_bf4(km + (size_t)row * 384 + (c >> 6) * 96 + (c & 63), v);
        else { bf16_t* base = vtml + ((size_t)((b * 4 + (c >> 6)) * 64 + (c & 63))) * SEQ + pos;
          _Pragma("unroll") for (int j = 0; j < 4; ++j) base[(size_t)j * SEQ] = f2bf(v[j]); }
      }
    )
  }
};

constexpr int LDS_K = 0, LDS_V = 16384;

template <int DQK, int DV, bool SB>
__device__ __forceinline__ void attn_pass(LAS unsigned char* lds, const bf16_t* Qg, int ldq, const bf16_t* Kg, int ldk, const bf16_t* VTg, int q0, float sc,
                                          f32x16 (&o)[DV / 32], float& lsum) {
  constexpr int KS = (DQK + 8) * 2, VS = 144, CK = DQK / 8, NKL = (64 * CK + 511) / 512, NVL = DV / 64, NKK = DQK / 16;
  const int tid = opaque_tid(), wid = tid >> 6, lane = tid & 63, l31 = lane & 31, hh = lane >> 5;
  const int qrow = q0 + wid * 32 + l31, qmin = q0 + wid * 32, qmax = qmin + 31;
  bf16x8 qf[NKK];
#pragma unroll
  for (int kk = 0; kk < NKK; ++kk) qf[kk] = *(const bf16x8*)(Qg + (size_t)qrow * ldq + kk * 16 + hh * 8);
#pragma unroll
  for (int db = 0; db < DV / 32; ++db)
#pragma unroll
    for (int r = 0; r < 16; ++r) o[db][r] = 0.f;
  float mrun = -INFINITY, lrun = 0.f, carry = 0.f;
  const int nt = (q0 + 256) / 64;
  u32x4 kreg[NKL], vreg[NVL];
  auto gload = [&](int k0) {
#pragma unroll
    for (int i = 0; i < NKL; ++i) { const int idx = tid + i * 512; if (idx < 64 * CK) { const int row = idx / CK, ch = idx % CK; kreg[i] = *(const u32x4*)(Kg + (size_t)(k0 + row) * ldk + ch * 8); } }
#pragma unroll
    for (int i = 0; i < NVL; ++i) { const int idx = tid + i * 512; const int d = idx >> 3, ch = idx & 7; vreg[i] = *(const u32x4*)(VTg + (size_t)d * SEQ + k0 + ch * 8); }
  };
  gload(SB ? (nt - 1) * 64 : 0);
  for (int it = 0; it < nt; ++it) {
    const int k0 = (SB ? (nt - 1 - it) : it) * 64;
    if (SB) {
      const bool wdone = (k0 + 64 <= qmax) && __all(carry < -110.0f);
      if (__syncthreads_and(wdone)) break;
    } else __syncthreads();
#pragma unroll
    for (int i = 0; i < NKL; ++i) { const int idx = tid + i * 512; if (idx < 64 * CK) { const int row = idx / CK, ch = idx % CK; *(LAS u32x4*)(lds + LDS_K + row * KS + ch * 16) = kreg[i]; } }
#pragma unroll
    for (int i = 0; i < NVL; ++i) { const int idx = tid + i * 512; const int d = idx >> 3, ch = idx & 7; *(LAS u32x4*)(lds + LDS_V + d * VS + ch * 16) = vreg[i]; }
    __syncthreads();
    if (it + 1 < nt) gload((SB ? (nt - 2 - it) : (it + 1)) * 64);
    if (k0 <= qmax) {
      f32x16 s[2];
#pragma unroll
      for (int kb = 0; kb < 2; ++kb) {
#pragma unroll
        for (int r = 0; r < 16; ++r) s[kb][r] = 0.f;
#pragma unroll
        for (int kk = 0; kk < NKK; ++kk) {
          const bf16x8 a = *(const LAS bf16x8*)(lds + LDS_K + (kb * 32 + l31) * KS + (kk * 16 + hh * 8) * 2);
          s[kb] = __builtin_amdgcn_mfma_f32_32x32x16_bf16(a, qf[kk], s[kb], 0, 0, 0);
        }
      }
      const bool diag = (k0 + 63 >= qmin);
      if (!SB) {
        float mx = -INFINITY;
        if (diag) {
#pragma unroll
          for (int kb = 0; kb < 2; ++kb)
#pragma unroll
            for (int r = 0; r < 16; ++r) { const int key = k0 + kb * 32 + 8 * (r >> 2) + 4 * hh + (r & 3); if (key > qrow) s[kb][r] = -INFINITY; }
        }
#pragma unroll
        for (int kb = 0; kb < 2; ++kb)
#pragma unroll
          for (int r = 0; r < 16; ++r) mx = fmaxf(mx, s[kb][r]);
        mx = fmaxf(mx, __shfl_xor(mx, 32));
        const float mnew = fmaxf(mrun, mx);
        if (!__all(mnew == mrun)) {
          const float alpha = fexp2((mrun - mnew) * sc);
          lrun *= alpha;
#pragma unroll
          for (int db = 0; db < DV / 32; ++db)
#pragma unroll
            for (int r = 0; r < 16; ++r) o[db][r] *= alpha;
          mrun = mnew;
        }
        const float msc = -mnew * sc;
#pragma unroll
        for (int kb = 0; kb < 2; ++kb)
#pragma unroll
          for (int r = 0; r < 16; ++r) { const float pv = fexp2(__builtin_fmaf(s[kb][r], sc, msc)); s[kb][r] = pv; lrun += pv; }
      } else {
        float lk[2][16];
#pragma unroll
        for (int kb = 0; kb < 2; ++kb)
#pragma unroll
          for (int r = 0; r < 16; ++r) {
            const float z = s[kb][r] * sc;
            const float e = fexp2(-fabsf(z) * LOG2E);
            const float lb = fminf(z, 0.f) - flog2(1.0f + e) * LN2;
            bool valid = true;
            if (diag) { const int key = k0 + kb * 32 + 8 * (r >> 2) + 4 * hh + (r & 3); valid = key < qrow; }
            s[kb][r] = valid ? lb : -INFINITY; lk[kb][r] = valid ? lb - z : 0.f;
          }
        float run = carry;
#pragma unroll
        for (int kb = 1; kb >= 0; --kb)
#pragma unroll
          for (int g = 3; g >= 0; --g) {
            const float G = (lk[kb][4 * g] + lk[kb][4 * g + 1]) + (lk[kb][4 * g + 2] + lk[kb][4 * g + 3]);
            const float Gp = __shfl_xor(G, 32);
            float bt = run + (hh == 0 ? Gp : 0.f);
            s[kb][4 * g + 3] = fexp2((s[kb][4 * g + 3] + bt) * LOG2E); bt += lk[kb][4 * g + 3];
            s[kb][4 * g + 2] = fexp2((s[kb][4 * g + 2] + bt) * LOG2E); bt += lk[kb][4 * g + 2];
            s[kb][4 * g + 1] = fexp2((s[kb][4 * g + 1] + bt) * LOG2E); bt += lk[kb][4 * g + 1];
            s[kb][4 * g + 0] = fexp2((s[kb][4 * g + 0] + bt) * LOG2E);
            run += G + Gp;
          }
        carry = run;
      }
#pragma unroll
      for (int kb = 0; kb < 2; ++kb)
#pragma unroll
        for (int s2 = 0; s2 < 2; ++s2) {
          u32x4 pw;
          pw.x = cvt_pk_bf16(s[kb][8 * s2 + 0], s[kb][8 * s2 + 1]); pw.y = cvt_pk_bf16(s[kb][8 * s2 + 2], s[kb][8 * s2 + 3]);
          pw.z = cvt_pk_bf16(s[kb][8 * s2 + 4], s[kb][8 * s2 + 5]); pw.w = cvt_pk_bf16(s[kb][8 * s2 + 6], s[kb][8 * s2 + 7]);
          const bf16x8 pf = __builtin_bit_cast(bf16x8, pw);
#pragma unroll
          for (int db = 0; db < DV / 32; ++db) {
            const bf16x8 a = *(const LAS bf16x8*)(lds + LDS_V + (db * 32 + l31) * VS + (kb * 32 + s2 * 16 + hh * 8) * 2);
            o[db] = __builtin_amdgcn_mfma_f32_32x32x16_bf16(a, pf, o[db], 0, 0, 0);
          }
        }
    }
  }
  lsum = lrun + __shfl_xor(lrun, 32);
}

constexpr int LDS_OUT = 49152;
template <int NDB>
__device__ __forceinline__ void attn_store(LAS unsigned char* lds, bf16_t* mixed, int tok0w, int col0, const f32x16 (&o)[NDB], int wid, int lane) {
  constexpr int RS = NDB * 64 + 16, CPR = NDB * 4;
  LAS unsigned char* reg = lds + LDS_OUT + wid * (32 * 272);
  const int l31 = lane & 31, hh = lane >> 5;
#pragma unroll
  for (int db = 0; db < NDB; ++db)
#pragma unroll
    for (int g = 0; g < 4; ++g) {
      u32x2 w; w.x = cvt_pk_bf16(o[db][4 * g], o[db][4 * g + 1]); w.y = cvt_pk_bf16(o[db][4 * g + 2], o[db][4 * g + 3]);
      *(LAS u32x2*)(reg + l31 * RS + (db * 32 + 8 * g + 4 * hh) * 2) = w;
    }
  asm volatile("s_waitcnt lgkmcnt(0)" ::: "memory");
#pragma unroll
  for (int i = 0; i < 32 * CPR / 64; ++i) {
    const int idx = i * 64 + lane, row = idx / CPR, ch = idx % CPR;
    const u32x4 w = *(const LAS u32x4*)(reg + row * RS + ch * 16);
    *(u32x4*)(mixed + (size_t)(tok0w + row) * D + col0 + ch * 8) = w;
  }
}

__device__ const unsigned char ATT_ORDER[48] = {
  31, 30, 29, 28, 27, 26, 25, 24, 23, 47, 22, 46, 45, 21, 44, 43, 20, 42, 41, 40, 19, 39, 38, 18, 15, 14, 13, 12, 11, 10, 9, 8, 7, 6, 5, 4, 3, 2, 37, 36, 17, 1, 35, 34, 16, 0, 33, 32
};

__device__ __forceinline__ void attn_phase(const Params& p, int layer, LAS unsigned char* lds, int* ctr, unsigned* up_done) {
  bool mla_ready = false;
  LAS int* slot = (LAS int*)(lds + 40960);
  for (;;) {
    unsigned char* ws = opq(p.ws);
    const bf16_t* qkv = (const bf16_t*)(ws + WS_QKV);
    bf16_t* mixed = (bf16_t*)(ws + WS_MIX);
    const int tid = opaque_tid(), wid = tid >> 6, lane = tid & 63, l31 = lane & 31, hh = lane >> 5;
    __syncthreads();
    if (tid == 0) *slot = atomicAdd(ctr, 1);
    __syncthreads();
    const int item = *slot;
    if (item >= 768) break;
    const int e = ATT_ORDER[item >> 4], type = e >> 4, qb = e & 15, bh = item & 15, b = bh >> 2, head = bh & 3;
    const int q0 = qb * 256, tok = b * SEQ + q0 + wid * 32 + l31;
    if (type == 2 && !mla_ready) {
      if (tid == 0) { unsigned sp = 0;
        while (__hip_atomic_load(up_done, __ATOMIC_RELAXED, __HIP_MEMORY_SCOPE_AGENT) < gridDim.x) { __builtin_amdgcn_s_sleep(2); if (++sp > (1u << 22)) break; }
        __builtin_amdgcn_fence(__ATOMIC_ACQUIRE, "agent"); asm volatile("s_waitcnt vmcnt(0)" ::: "memory"); }
      __syncthreads();
      mla_ready = true;
    }
    if (type == 0) {
      f32x16 o[2]; float l;
      attn_pass<64, 64, true>(lds, qkv + (size_t)b * SEQ * QW + head * 64, QW, qkv + (size_t)b * SEQ * QW + 256 + head * 64, QW,
                              (const bf16_t*)(ws + WS_VTSB) + (size_t)bh * 64 * SEQ, q0, 0.125f, o, l);
      attn_store<2>(lds, mixed, tok - l31, head * 64, o, wid, lane);
    } else if (type == 1) {
      const float* lq1 = p.in[12] + layer * 64; const float* lk1 = p.in[13] + layer * 64; const float* lq2 = p.in[14] + layer * 64; const float* lk2 = p.in[15] + layer * 64;
      const float linit = 0.8f - 0.6f * expf(-0.3f * (float)layer);
      const float lam = expf(wave_sum(lq1[lane] * lk1[lane])) - expf(wave_sum(lq2[lane] * lk2[lane])) + linit;
      f32x16 o1[4]; float l1, l2;
      const bf16_t* vt = (const bf16_t*)(ws + WS_VTDF) + (size_t)bh * 128 * SEQ;
      f32x4* stash = (f32x4*)(ws + WS_STASH) + (size_t)blockIdx.x * 16 * 512 + tid;
      attn_pass<64, 128, false>(lds, qkv + (size_t)b * SEQ * QW + 768 + head * 128, QW, qkv + (size_t)b * SEQ * QW + 1280 + head * 128, QW, vt, q0, 0.125f * LOG2E, o1, l1);
      { const float inv = 1.0f / l1;
#pragma unroll
        for (int db = 0; db < 4; ++db)
#pragma unroll
          for (int g = 0; g < 4; ++g) { f32x4 v; v[0] = o1[db][4 * g] * inv; v[1] = o1[db][4 * g + 1] * inv; v[2] = o1[db][4 * g + 2] * inv; v[3] = o1[db][4 * g + 3] * inv; stash[(db * 4 + g) * 512] = v; } }
      attn_pass<64, 128, false>(lds, qkv + (size_t)b * SEQ * QW + 768 + head * 128 + 64, QW, qkv + (size_t)b * SEQ * QW + 1280 + head * 128 + 64, QW, vt, q0, 0.125f * LOG2E, o1, l2);
      { const float inv = lam / l2; float sq = 0.f;
#pragma unroll
        for (int db = 0; db < 4; ++db)
#pragma unroll
          for (int g = 0; g < 4; ++g) { const f32x4 a = stash[(db * 4 + g) * 512];
#pragma unroll
            for (int j = 0; j < 4; ++j) { const float v = a[j] - o1[db][4 * g + j] * inv; o1[db][4 * g + j] = v; sq += v * v; } }
        sq += __shfl_xor(sq, 32);
        const float rs = rsqrtf(sq * (1.0f / 128) + EPS) * (1.0f - linit);
        const float* gsub = p.in[16] + layer * 128;
#pragma unroll
        for (int db = 0; db < 4; ++db)
#pragma unroll
          for (int g = 0; g < 4; ++g) { const f32x4 gv = *(const f32x4*)(gsub + db * 32 + 8 * g + 4 * hh);
#pragma unroll
            for (int j = 0; j < 4; ++j) o1[db][4 * g + j] *= rs * gv[j]; } }
      attn_store<4>(lds, mixed, tok - l31, 256 + head * 128, o1, wid, lane);
    } else {
      f32x16 o[2]; float l;
      attn_pass<96, 64, false>(lds, (const bf16_t*)(ws + WS_QM) + (size_t)b * SEQ * 384 + head * 96, 384, (const bf16_t*)(ws + WS_KM) + (size_t)b * SEQ * 384 + head * 96, 384,
                               (const bf16_t*)(ws + WS_VTML) + (size_t)bh * 64 * SEQ, q0, 0.10206207261596577f * LOG2E, o, l);
      const float inv = 1.0f / l;
#pragma unroll
      for (int db = 0; db < 2; ++db)
#pragma unroll
        for (int r = 0; r < 16; ++r) o[db][r] *= inv;
      attn_store<2>(lds, mixed, tok - l31, 768 + head * 64, o, wid, lane);
    }
  }
}

struct WDesc { const float* src; bf16_t* dst; const float* gain; int K, Kpad, Nsrc, Npad, mode; };
__device__ __forceinline__ void get_wdesc(const Params& p, int layer, int kind, WDesc& d) {
  unsigned char* wl = p.ws + WS_W + (size_t)layer * SZ_WL;
  d.gain = nullptr; d.mode = 0;
  switch (kind) {
    case 0: d.src = p.in[4] + (size_t)layer * D * GU; d.dst = (bf16_t*)(wl + WO_GU1); d.gain = p.in[3] + layer * D; d.K = D; d.Kpad = D; d.Nsrc = GU; d.Npad = GU; d.mode = 1; break;
    case 1: d.src = p.in[5] + (size_t)layer * FF * D; d.dst = (bf16_t*)(wl + WO_D1); d.K = FF; d.Kpad = FF; d.Nsrc = D; d.Npad = D; break;
    case 2: d.src = p.in[7] + (size_t)layer * D * 2720; d.dst = (bf16_t*)(wl + WO_IN); d.gain = p.in[6] + layer * D; d.K = D; d.Kpad = D; d.Nsrc = 2720; d.Npad = NQ; break;
    case 3: d.src = p.in[9] + (size_t)layer * 256 * 384; d.dst = (bf16_t*)(wl + WO_UPQ); d.gain = p.in[8] + layer * 256; d.K = 256; d.Kpad = 256; d.Nsrc = 384; d.Npad = 512; break;
    case 4: d.src = p.in[11] + (size_t)layer * 128 * 512; d.dst = (bf16_t*)(wl + WO_UPKV); d.gain = p.in[10] + layer * 128; d.K = 128; d.Kpad = 256; d.Nsrc = 512; d.Npad = 512; d.mode = 2; break;
    case 5: d.src = p.in[17] + (size_t)layer * D * D; d.dst = (bf16_t*)(wl + WO_OUT); d.K = D; d.Kpad = D; d.Nsrc = D; d.Npad = D; break;
    case 6: d.src = p.in[19] + (size_t)layer * D * GU; d.dst = (bf16_t*)(wl + WO_GU2); d.gain = p.in[18] + layer * D; d.K = D; d.Kpad = D; d.Nsrc = GU; d.Npad = GU; d.mode = 1; break;
    case 7: d.src = p.in[20] + (size_t)layer * FF * D; d.dst = (bf16_t*)(wl + WO_D2); d.K = FF; d.Kpad = FF; d.Nsrc = D; d.Npad = D; break;
    case 8: d.src = p.in[22] + (size_t)layer * D * D; d.dst = (bf16_t*)(wl + WO_GATE); d.gain = p.in[21] + layer * D; d.K = D; d.Kpad = D; d.Nsrc = D; d.Npad = D; break;
    default: d.src = p.in[23] + (size_t)layer * 256 * D; d.dst = (bf16_t*)(wl + WO_PJ); d.K = 256; d.Kpad = 256; d.Nsrc = D; d.Npad = D; break;
  }
}
__device__ __forceinline__ int wsrc_col(int mode, int n, int Nsrc) {
  if (mode == 1) return ((n >> 7) & 1) * FF + (n >> 8) * 128 + (n & 127);
  if (mode == 2) return n < 256 ? (n >> 6) * 128 + (n & 63) : ((n - 256) >> 6) * 128 + 64 + (n & 63);
  return n < Nsrc ? n : -1;
}

__device__ __forceinline__ void prologue(const Params& p, LAS unsigned char* lds) {
  const int tid = opaque_tid(), nb = gridDim.x, bid = blockIdx.x;
  unsigned char* ws = p.ws;
  if (bid == 0 && tid < 64) ((int*)(ws + WS_CTR))[tid] = 0;
  { float* cosd = (float*)(ws + WS_ROPE); float* sind = cosd + T * 8; float* cosm = sind + T * 8; float* sinm = cosm + T * 16;
    const int* pos = (const int*)p.in[2];
    for (int i = bid * 512 + tid; i < T * 24; i += nb * 512) {
      int tok, j; float invf;
      if (i < T * 8) { tok = i >> 3; j = i & 7; invf = 1.0f / powf(500000.0f, (float)(2 * j) / 16.0f); }
      else { const int k = i - T * 8; tok = k >> 4; j = k & 15; invf = 1.0f / powf(500000.0f, (float)(2 * j) / 32.0f); }
      const float ang = (float)pos[tok] * invf;
      double rev = (double)ang * 0.15915494309189535; rev -= rint(rev);
      const float rr = (float)(rev * 6.283185307179586);
      const float c = __cosf(rr), s = __sinf(rr);
      if (i < T * 8) { cosd[tok * 8 + j] = c; sind[tok * 8 + j] = s; } else { cosm[tok * 16 + j] = c; sinm[tok * 16 + j] = s; }
    } }
  { const f32x4* src = (const f32x4*)p.in[1]; u32x2* dst = (u32x2*)(ws + WS_PB); const size_t n = (size_t)NL * T * 256 / 4;
    const size_t stride = (size_t)nb * 512;
    size_t i = (size_t)bid * 512 + tid;
    for (; i + 3 * stride < n; i += 4 * stride) {
      f32x4 v[4];
#pragma unroll
      for (int u = 0; u < 4; ++u) v[u] = __builtin_nontemporal_load(src + i + u * stride);
#pragma unroll
      for (int u = 0; u < 4; ++u) { u32x2 w; w.x = cvt_pk_bf16(v[u][0], v[u][1]); w.y = cvt_pk_bf16(v[u][2], v[u][3]); dst[i + u * stride] = w; }
    }
    for (; i < n; i += stride) { const f32x4 v = src[i]; u32x2 w; w.x = cvt_pk_bf16(v[0], v[1]); w.y = cvt_pk_bf16(v[2], v[3]); dst[i] = w; } }
  { const int wid = tid >> 6, lane = tid & 63; float* ssq0 = (float*)(ws + WS_SSQ); bf16_t* hb = (bf16_t*)(ws + WS_HB);
    for (int row = bid * 8 + wid; row < T; row += nb * 8) {
      float sq = 0.f;
#pragma unroll
      for (int i = 0; i < 4; ++i) { const size_t off = (size_t)row * D + i * 256 + lane * 4; const f32x4 v = *(const f32x4*)(p.in[0] + off);
        store_bf4(hb + off, v); sq += v[0] * v[0] + v[1] * v[1] + v[2] * v[2] + v[3] * v[3]; }
      sq = wave_sum(sq);
      if (lane < 16) ssq0[(size_t)row * 16 + lane] = lane == 0 ? sq : 0.f;
    } }
  { constexpr int NT_KIND[10] = {1408, 704, 704, 32, 32, 256, 1408, 704, 256, 64};
    constexpr int PER_LAYER = 5568;
    const int wid = tid >> 6, lane = tid & 63;
    for (int t = bid * 8 + wid; t < NL * PER_LAYER; t += nb * 8) {
      const int layer = t / PER_LAYER; int r = t % PER_LAYER, kind = 0;
#pragma unroll
      for (int k = 0; k < 9; ++k) { if (kind == k && r >= NT_KIND[k]) { r -= NT_KIND[k]; kind = k + 1; } }
      WDesc d; get_wdesc(p, layer, kind, d);
      const int nkt = d.Kpad / 64, n0 = (r / nkt) * 64, k0 = (r % nkt) * 64;
      const int sc = wsrc_col(d.mode, n0 + lane, d.Nsrc);
      const bool live = sc >= 0 && k0 < d.K;
      const float* sp = d.src + (size_t)k0 * d.Nsrc + (sc >= 0 ? sc : 0);
      bf16_t* dp = d.dst + (size_t)(n0 + lane) * d.Kpad + k0;
      float v[64];
#pragma unroll
      for (int e = 0; e < 64; ++e) v[e] = live ? __builtin_nontemporal_load(sp + (size_t)e * d.Nsrc) : 0.f;
      if (d.gain && live) {
#pragma unroll
        for (int e = 0; e < 64; ++e) v[e] *= d.gain[k0 + e];
      }
#pragma unroll
      for (int kc = 0; kc < 8; ++kc) {
        u32x4 w; w.x = cvt_pk_bf16(v[kc * 8 + 0], v[kc * 8 + 1]); w.y = cvt_pk_bf16(v[kc * 8 + 2], v[kc * 8 + 3]); w.z = cvt_pk_bf16(v[kc * 8 + 4], v[kc * 8 + 5]); w.w = cvt_pk_bf16(v[kc * 8 + 6], v[kc * 8 + 7]);
        *(u32x4*)(dp + kc * 8) = w;
      }
    }
  }
}

__device__ __forceinline__ void rope_sweep(const Params& p) {
  unsigned char* ws = opq(p.ws); const bf16_t* ckv = (const bf16_t*)(ws + WS_CKV); bf16_t* km = (bf16_t*)(ws + WS_KM);
  const float* cosm = (const float*)(ws + WS_ROPE) + T * 16; const float* sinm = cosm + T * 16;
  for (int tok = blockIdx.x * 512 + opaque_tid(); tok < T; tok += gridDim.x * 512) {
    const bf16_t* src = ckv + (size_t)tok * 256 + 128;
    float x[32];
#pragma unroll
    for (int q = 0; q < 4; ++q) { const u32x4 w = *(const u32x4*)(src + q * 8); const unsigned* wp = (const unsigned*)&w;
#pragma unroll
      for (int j = 0; j < 4; ++j) { x[q * 8 + 2 * j] = bf2f(wp[j] & 0xffffu); x[q * 8 + 2 * j + 1] = __uint_as_float(wp[j] & 0xffff0000u); } }
    unsigned o[16];
#pragma unroll
    for (int j = 0; j < 16; j += 2) {
      const float c0 = cosm[tok * 16 + j], s0 = sinm[tok * 16 + j], c1 = cosm[tok * 16 + j + 1], s1 = sinm[tok * 16 + j + 1];
      o[j / 2] = cvt_pk_bf16(x[j] * c0 - x[j + 16] * s0, x[j + 1] * c1 - x[j + 17] * s1);
      o[8 + j / 2] = cvt_pk_bf16(x[j + 16] * c0 + x[j] * s0, x[j + 17] * c1 + x[j + 1] * s1);
    }
#pragma unroll
    for (int h = 0; h < 4; ++h) { u32x4* dst = (u32x4*)(km + (size_t)tok * 384 + h * 96 + 64);
#pragma unroll
      for (int q = 0; q < 4; ++q) { u32x4 w; w.x = o[q * 4]; w.y = o[q * 4 + 1]; w.z = o[q * 4 + 2]; w.w = o[q * 4 + 3]; dst[q] = w; } }
  }
}

__device__ __forceinline__ void final_norm(const Params& p) {
  const int tid = opaque_tid(), wid = tid >> 6, lane = tid & 63; const float* ssq = (const float*)(p.ws + WS_SSQ); const float* gain = p.in[24];
  for (int row = blockIdx.x * 8 + wid; row < T; row += gridDim.x * 8) {
    const float rs = rsqrtf(sum16(ssq + (size_t)row * 16) * (1.0f / D) + EPS);
#pragma unroll
    for (int i = 0; i < 4; ++i) { const size_t off = (size_t)row * D + i * 256 + lane * 4; f32x4 v = load_bf4((const bf16_t*)(p.ws + WS_HB2) + off); const f32x4 g = *(const f32x4*)(gain + i * 256 + lane * 4);
      v = v * rs * g;
      *(f32x4*)(p.out + off) = v; }
  }
}

constexpr int LDS_BYTES = pg8::STAGE_BYTES + 16;

__global__ void __launch_bounds__(512) mk_forward(Params p) {
  extern __shared__ __attribute__((aligned(16))) unsigned char smem[];
  LAS unsigned char* lds = (LAS unsigned char*)smem;
  cg::grid_group grid = cg::this_grid();
  if (threadIdx.x == 0) { *(LAS u32x4*)(lds + pg8::STAGE_BYTES) = (u32x4){0u, 0u, 0u, 0u}; }
  __syncthreads();
  const XcdBarrier xbar = xcd_barrier_post((unsigned*)(p.ws + WS_BAR), (volatile LAS unsigned*)(lds + pg8::STAGE_BYTES));
  unsigned char* ws = p.ws;
  const int G = gridDim.x;

  prologue(p, lds);
  grid.sync();
  { volatile LAS unsigned* st = (volatile LAS unsigned*)(lds + pg8::STAGE_BYTES);
    if (threadIdx.x == 0) {
      unsigned* bar = (unsigned*)(p.ws + WS_BAR); unsigned nx = 0, idx = 0, per = 0; bool ok = true;
      for (unsigned j = 0; j < 16; ++j) { const unsigned c = xb_ld(&bar[XB_XCNT(j)]); if (c) { if (j < xbar.x) ++idx; ++nx; if (per == 0) per = c; else if (c != per) ok = false; } }
      ok = ok && nx == 8u && per * nx == (unsigned)G && st[2] < per;
      st[3] = ok ? (0x80000000u | (st[2] * nx + idx)) : blockIdx.x;
    }
    __syncthreads(); }
  const unsigned vbw = ((volatile LAS unsigned*)(lds + pg8::STAGE_BYTES))[3];
  const int bid0 = __builtin_amdgcn_readfirstlane((int)(vbw & 0x7fffffffu));
  const bool local_ok = __builtin_amdgcn_readfirstlane((int)(vbw >> 31)) != 0;
#define SEAM_LOCAL() do { if (local_ok) xcd_barrier_local(xbar); else xcd_barrier(xbar); } while (0)

  for (int layer = 0; layer < NL; ++layer) {
    int bid = bid0; asm volatile("" : "+s"(bid));
    pg8::StaticOrder so;
    const size_t HB1 = layer ? WS_HB2 : WS_HB;
    { unsigned char* w = opq(ws); unsigned char* wl = w + WS_W + (size_t)layer * SZ_WL; float* sA = (float*)(w + WS_SSQ); float* sB = sA + (size_t)T * 16;
      so.init(T, GU, G, bid); pg8::gemm_phase<true>(lds, pg8::Gemm{(const bf16_t*)(w + HB1), (const bf16_t*)(wl + WO_GU1), T, GU, D}, so, EpiGU{sA, (bf16_t*)(w + WS_ACT)}); }
    SEAM_LOCAL();
    { unsigned char* w = opq(ws); unsigned char* wl = w + WS_W + (size_t)layer * SZ_WL; float* sA = (float*)(w + WS_SSQ); float* sB = sA + (size_t)T * 16;
      so.init(T, D, G, bid); pg8::gemm_phase<true>(lds, pg8::Gemm{(const bf16_t*)(w + WS_ACT), (const bf16_t*)(wl + WO_D1), T, D, FF}, so, EpiResP{layer ? (const float*)nullptr : opq(p.in[0]), (const bf16_t*)(w + WS_HB2), (bf16_t*)(w + WS_HB), sB, 0.5f}); }
    xcd_barrier(xbar);
    { unsigned char* w = opq(ws); unsigned char* wl = w + WS_W + (size_t)layer * SZ_WL; float* sA = (float*)(w + WS_SSQ); float* sB = sA + (size_t)T * 16;
      so.init(T, NQ, G, bid); pg8::gemm_phase(lds, pg8::Gemm{(const bf16_t*)(w + WS_HB), (const bf16_t*)(wl + WO_IN), T, NQ, D}, so,
        EpiWin{sB, (bf16_t*)(w + WS_QKV), (bf16_t*)(w + WS_CQ), (bf16_t*)(w + WS_CKV), (bf16_t*)(w + WS_VTSB), (bf16_t*)(w + WS_VTDF),
               (float*)(w + WS_SSQQ), (float*)(w + WS_SSQKV), (const float*)(w + WS_ROPE), (const float*)(w + WS_ROPE) + T * 8}); }
    xcd_barrier(xbar);
    { unsigned char* w = opq(ws); unsigned char* wl = w + WS_W + (size_t)layer * SZ_WL;
      const float* cosm = (const float*)(w + WS_ROPE) + T * 16; const float* sinm = cosm + T * 16;
      so.init(T, 512, G, bid < G / 2 ? bid : -1); pg8::gemm_phase(lds, pg8::Gemm{(const bf16_t*)(w + WS_CQ), (const bf16_t*)(wl + WO_UPQ), T, 512, 256}, so,
        EpiUpQ{(float*)(w + WS_SSQQ), (bf16_t*)(w + WS_QM), cosm, sinm});
      so.init(T, 512, G - G / 2, bid >= G / 2 ? bid - G / 2 : -1); pg8::gemm_phase(lds, pg8::Gemm{(const bf16_t*)(w + WS_CKV), (const bf16_t*)(wl + WO_UPKV), T, 512, 256}, so,
        EpiUpKV{(float*)(w + WS_SSQKV), (bf16_t*)(w + WS_KM), (bf16_t*)(w + WS_VTML)});
      rope_sweep(p); }
    { asm volatile("s_waitcnt vmcnt(0)" ::: "memory"); __syncthreads();
      if (threadIdx.x == 0) { __builtin_amdgcn_fence(__ATOMIC_RELEASE, "agent"); asm volatile("s_waitcnt vmcnt(0)" ::: "memory");
        __hip_atomic_fetch_add((unsigned*)(opq(ws) + WS_CTR) + 16 + layer, 1u, __ATOMIC_RELAXED, __HIP_MEMORY_SCOPE_AGENT); } }
    attn_phase(p, layer, lds, (int*)(opq(ws) + WS_CTR) + layer, (unsigned*)(opq(ws) + WS_CTR) + 16 + layer);
    xcd_barrier(xbar);
    { unsigned char* w = opq(ws); unsigned char* wl = w + WS_W + (size_t)layer * SZ_WL; float* sA = (float*)(w + WS_SSQ); float* sB = sA + (size_t)T * 16;
      so.init(T, D, G, bid); pg8::gemm_phase<true>(lds, pg8::Gemm{(const bf16_t*)(w + WS_MIX), (const bf16_t*)(wl + WO_OUT), T, D, D}, so, EpiResP{(const float*)nullptr, (const bf16_t*)(w + WS_HB), (bf16_t*)(w + WS_HB), sA, 1.0f}); }
    SEAM_LOCAL();
    { unsigned char* w = opq(ws); unsigned char* wl = w + WS_W + (size_t)layer * SZ_WL; float* sA = (float*)(w + WS_SSQ); float* sB = sA + (size_t)T * 16;
      so.init(T, GU, G, bid); pg8::gemm_phase<true>(lds, pg8::Gemm{(const bf16_t*)(w + WS_HB), (const bf16_t*)(wl + WO_GU2), T, GU, D}, so, EpiGU{sA, (bf16_t*)(w + WS_ACT)});
      so.init(T, D, G - G / 2, bid >= G / 2 ? bid - G / 2 : -1); pg8::gemm_phase(lds, pg8::Gemm{(const bf16_t*)(w + WS_PB) + (size_t)layer * T * 256, (const bf16_t*)(wl + WO_PJ), T, D, 256}, so, EpiProj{(bf16_t*)(w + WS_MIX)}); }
    SEAM_LOCAL();
    { unsigned char* w = opq(ws); unsigned char* wl = w + WS_W + (size_t)layer * SZ_WL; float* sA = (float*)(w + WS_SSQ); float* sB = sA + (size_t)T * 16;
      so.init(T, D, G, bid); pg8::gemm_phase<true>(lds, pg8::Gemm{(const bf16_t*)(w + WS_ACT), (const bf16_t*)(wl + WO_D2), T, D, FF}, so, EpiResP{(const float*)nullptr, (const bf16_t*)(w + WS_HB), (bf16_t*)(w + WS_HB), sB, 0.5f}); }
    SEAM_LOCAL();
    { unsigned char* w = opq(ws); unsigned char* wl = w + WS_W + (size_t)layer * SZ_WL; float* sA = (float*)(w + WS_SSQ); float* sB = sA + (size_t)T * 16;
      so.init(T, D, G, bid); pg8::gemm_phase<true>(lds, pg8::Gemm{(const bf16_t*)(w + WS_HB), (const bf16_t*)(wl + WO_GATE), T, D, D}, so, EpiPleP{sB, (const bf16_t*)(w + WS_MIX), (const bf16_t*)(w + WS_HB), (bf16_t*)(w + WS_HB2), sA}); }
    if (layer + 1 < NL) SEAM_LOCAL(); else xcd_barrier(xbar);
  }
  final_norm(p);
}

extern "C" void kernel_launch(void* const* d_in, const int* in_sizes, int n_in, void* d_out, int out_size, void* d_ws, size_t ws_size, hipStream_t stream) {
  static int grid = 0;
  if (grid == 0) {
    int dev = 0, cus = 0, per_cu = 0;
    if (n_in != 25 || out_size != T * D || ws_size < WS_END) { fprintf(stderr, "kernel_launch: unexpected shapes (n_in %d out %d ws %zu need %zu)\n", n_in, out_size, ws_size, (size_t)WS_END); grid = -1; return; }
    (void)hipGetDevice(&dev);
    (void)hipDeviceGetAttribute(&cus, hipDeviceAttributeMultiprocessorCount, dev);
    if (hipFuncSetAttribute((const void*)mk_forward, hipFuncAttributeMaxDynamicSharedMemorySize, LDS_BYTES) != hipSuccess) { fprintf(stderr, "kernel_launch: hipFuncSetAttribute failed\n"); grid = -1; return; }
    (void)hipOccupancyMaxActiveBlocksPerMultiprocessor(&per_cu, (const void*)mk_forward, 512, LDS_BYTES);
    (void)hipGetLastError();
    if (per_cu < 1) fprintf(stderr, "kernel_launch: occupancy query says %d blocks per CU\n", per_cu);
    grid = cus;
  }
  if (grid < 0) return;
  Params p{};
  for (int i = 0; i < 25; ++i) p.in[i] = (const float*)d_in[i];
  p.out = (float*)d_out; p.ws = (unsigned char*)d_ws;
  if (hipMemsetAsync((unsigned char*)d_ws + WS_BAR, 0, XCD_BAR_WORDS * 4, stream) != hipSuccess) { fprintf(stderr, "kernel_launch: memset of the barrier words failed\n"); return; }
  void* args[] = {&p};
  hipError_t e = hipLaunchCooperativeKernel((const void*)mk_forward, dim3(grid), dim3(512), args, LDS_BYTES, stream);
  if (e != hipSuccess) fprintf(stderr, "kernel_launch: cooperative launch failed: %s (grid %d)\n", hipGetErrorString(e), grid);
}
```

```cpp
#include <hip/hip_runtime.h>
#include <hip/hip_cooperative_groups.h>
#include <cstdio>
namespace cg = cooperative_groups;

#define LAS __attribute__((address_space(3)))
typedef unsigned short bf16_t;
typedef short bf16x8 __attribute__((ext_vector_type(8)));
typedef float f32x4 __attribute__((ext_vector_type(4)));
typedef float f32x16 __attribute__((ext_vector_type(16)));
typedef unsigned u32x4 __attribute__((ext_vector_type(4)));
typedef unsigned u32x2 __attribute__((ext_vector_type(2)));

constexpr int T = 16384, SEQ = 4096, D = 1024, FF = 2816, GU = 5632, NQ = 2816, QW = 2304, NL = 4;
constexpr float EPS = 1e-6f;
constexpr float LOG2E = 1.4426950408889634f, LN2 = 0.6931471805599453f;

constexpr size_t al(size_t x) { return (x + 255) & ~(size_t)255; }
constexpr size_t SZ_WGU = (size_t)GU * D * 2, SZ_WD = (size_t)D * FF * 2, SZ_WIN = (size_t)NQ * D * 2, SZ_WUP = (size_t)512 * 256 * 2,
                 SZ_WSQ = (size_t)D * D * 2, SZ_WPJ = (size_t)D * 256 * 2;
constexpr size_t WO_GU1 = 0, WO_D1 = WO_GU1 + SZ_WGU, WO_IN = WO_D1 + SZ_WD, WO_UPQ = WO_IN + SZ_WIN, WO_UPKV = WO_UPQ + SZ_WUP,
                 WO_OUT = WO_UPKV + SZ_WUP, WO_GU2 = WO_OUT + SZ_WSQ, WO_D2 = WO_GU2 + SZ_WGU, WO_GATE = WO_D2 + SZ_WD, WO_PJ = WO_GATE + SZ_WSQ,
                 SZ_WL = WO_PJ + SZ_WPJ;
constexpr size_t WS_W = 0;
constexpr size_t WS_HB = al(WS_W + NL * SZ_WL);
constexpr size_t WS_ACT = al(WS_HB + (size_t)T * D * 2);
constexpr size_t WS_QKV = WS_ACT;
constexpr size_t WS_CQ = al(WS_QKV + (size_t)T * QW * 2);
constexpr size_t WS_CKV = al(WS_CQ + (size_t)T * 256 * 2);
constexpr size_t WS_ACT_END = al(WS_CKV + (size_t)T * 256 * 2) > al(WS_ACT + (size_t)T * FF * 2) ? al(WS_CKV + (size_t)T * 256 * 2) : al(WS_ACT + (size_t)T * FF * 2);
constexpr size_t WS_MIX = WS_ACT_END;
constexpr size_t WS_PB = al(WS_MIX + (size_t)T * D * 2);
constexpr size_t WS_VTSB = al(WS_PB + (size_t)NL * T * 256 * 2);
constexpr size_t WS_VTDF = al(WS_VTSB + (size_t)16 * 64 * SEQ * 2);
constexpr size_t WS_VTML = al(WS_VTDF + (size_t)16 * 128 * SEQ * 2);
constexpr size_t WS_QM = al(WS_VTML + (size_t)16 * 64 * SEQ * 2);
constexpr size_t WS_KM = al(WS_QM + (size_t)T * 384 * 2);
constexpr size_t WS_SSQ = al(WS_KM + (size_t)T * 384 * 2);
constexpr size_t WS_SSQQ = WS_SSQ + (size_t)2 * T * 16 * 4;
constexpr size_t WS_SSQKV = WS_SSQQ + (size_t)T * 4 * 4;
constexpr size_t WS_CTR = WS_SSQKV + (size_t)T * 4 * 4;
constexpr size_t WS_BAR = al(WS_CTR + 256);
constexpr size_t WS_ROPE = al(WS_BAR + 5504 * 4);
constexpr size_t WS_STASH = al(WS_ROPE + (size_t)T * 48 * 4);
constexpr size_t WS_END = al(WS_STASH + (size_t)256 * 16 * 512 * 16);
constexpr size_t WS_HB2 = WS_VTML;
static_assert(WS_HB2 + (size_t)T * D * 2 <= WS_SSQ, "hb2 alias overflows");

struct Params { const float* in[25]; float* out; unsigned char* ws; };

typedef __bf16 bf16x2_t __attribute__((ext_vector_type(2)));
typedef float f32x2_t __attribute__((ext_vector_type(2)));
__device__ __forceinline__ unsigned cvt_pk_bf16(float lo, float hi) { f32x2_t v = {lo, hi}; bf16x2_t b = __builtin_convertvector(v, bf16x2_t); return __builtin_bit_cast(unsigned, b); }
__device__ __forceinline__ bf16_t f2bf(float f) { unsigned u = __float_as_uint(f); u += 0x7FFFu + ((u >> 16) & 1u); return (bf16_t)(u >> 16); }
__device__ __forceinline__ float bf2f(unsigned v) { return __uint_as_float(v << 16); }
__device__ __forceinline__ float fexp2(float x) { return __builtin_amdgcn_exp2f(x); }
__device__ __forceinline__ float flog2(float x) { return __builtin_amdgcn_logf(x); }
__device__ __forceinline__ float frcp(float x) { return __builtin_amdgcn_rcpf(x); }
__device__ __forceinline__ int opaque_tid() { int t = threadIdx.x; asm volatile("" : "+v"(t)); return t; }
template <class P> __device__ __forceinline__ P* opq(P* p) { unsigned z; asm volatile("s_mov_b32 %0, 0" : "=s"(z)); return (P*)((unsigned char*)p + z); }
__device__ __forceinline__ float sum16(const float* p) { const f32x4 a = *(const f32x4*)p, b = *(const f32x4*)(p + 4), c = *(const f32x4*)(p + 8), d = *(const f32x4*)(p + 12);
  return (((a[0] + a[1]) + (a[2] + a[3])) + ((b[0] + b[1]) + (b[2] + b[3]))) + (((c[0] + c[1]) + (c[2] + c[3])) + ((d[0] + d[1]) + (d[2] + d[3]))); }
__device__ __forceinline__ float sum4(const float* p) { const f32x4 a = *(const f32x4*)p; return (a[0] + a[1]) + (a[2] + a[3]); }
__device__ __forceinline__ float wave_sum(float v) {
  v += __shfl_xor(v, 32); v += __shfl_xor(v, 16); v += __shfl_xor(v, 8); v += __shfl_xor(v, 4); v += __shfl_xor(v, 2); v += __shfl_xor(v, 1); return v;
}


#define XB_TMO      128
#define XB_XCNT(j)  (256  + 64 * (j))
#define XB_XSUB(j)  (1280 + 64 * (j))
#define XB_XGEN(j)  (2304 + 64 * (j))
#define XB_TOP      3328
#define XB_TOPGEN   3392
#define XB_LSUB(j)  (3456 + 64 * (j))
#define XB_LGEN(j)  (4480 + 64 * (j))
#define XCD_BAR_WORDS 5504
#define XB_SPIN_CAP (1u << 18)
__device__ __forceinline__ unsigned xb_ld(unsigned* p)              { return __hip_atomic_load(p, __ATOMIC_RELAXED, __HIP_MEMORY_SCOPE_AGENT); }
__device__ __forceinline__ unsigned xb_add(unsigned* p, unsigned v) { return __hip_atomic_fetch_add(p, v, __ATOMIC_RELAXED, __HIP_MEMORY_SCOPE_AGENT); }
__device__ __forceinline__ unsigned xb_xcc_id() { return (unsigned)__builtin_amdgcn_s_getreg((3 << 11) | 20) & 0xFu; }
#define XB_SPIN(cond, bar) do { unsigned _sp = 0; while (cond) { __builtin_amdgcn_s_sleep(1); \
    if ((++_sp & 255u) == 0u) { if (xb_ld(&(bar)[XB_TMO])) break; if (_sp > XB_SPIN_CAP) { atomicAdd(&(bar)[XB_TMO], 1u); break; } } } } while (0)
struct XcdBarrier { unsigned* bar; unsigned x; volatile LAS unsigned* st; };
__device__ __forceinline__ XcdBarrier xcd_barrier_post(unsigned* bar, volatile LAS unsigned* st) {
  XcdBarrier b; b.bar = bar; b.x = xb_xcc_id(); b.st = st;
  if (threadIdx.x == 0) st[2] = xb_add(&bar[XB_XCNT(b.x)], 1u);
  return b;
}
__device__ __forceinline__ void xcd_barrier_complete(unsigned* bar, unsigned x, unsigned& nloc, unsigned& nx) {
  const unsigned G = gridDim.x * gridDim.y * gridDim.z;
  unsigned sum, cnt, mine, sp = 0u;
  for (;;) {
    sum = 0u; cnt = 0u; mine = 0u;
#pragma unroll
    for (unsigned j = 0; j < 16; ++j) { const unsigned c = xb_ld(&bar[XB_XCNT(j)]); sum += c; cnt += (c > 0u) ? 1u : 0u; mine = (j == x) ? c : mine; }
    if (sum == G) break;
    __builtin_amdgcn_s_sleep(1);
    if ((++sp & 255u) == 0u) { if (xb_ld(&bar[XB_TMO])) break; if (sp > XB_SPIN_CAP) { atomicAdd(&bar[XB_TMO], 1u); break; } }
  }
  nloc = mine > 0u ? mine : 1u; nx = cnt > 0u ? cnt : 1u;
}
__device__ __forceinline__ void xcd_barrier(const XcdBarrier& b) {
  asm volatile("s_waitcnt vmcnt(0)" ::: "memory");
  __syncthreads();
  if (threadIdx.x == 0) {
    unsigned* bar = b.bar;
    __builtin_amdgcn_s_waitcnt(0);
    unsigned nloc = b.st[0], nx = b.st[1];
    if (nloc == 0u) { xcd_barrier_complete(bar, b.x, nloc, nx); b.st[0] = nloc; b.st[1] = nx; }
    const unsigned old = xb_add(&bar[XB_XSUB(b.x)], 1u);
    const unsigned gen = old / nloc;
    if (old + 1u == (gen + 1u) * nloc) {
      __builtin_amdgcn_fence(__ATOMIC_RELEASE, "agent");
      asm volatile("s_waitcnt vmcnt(0)" ::: "memory");
      const unsigned og = xb_add(&bar[XB_TOP], 1u);
      const unsigned tg = og / nx;
      if (og + 1u == (tg + 1u) * nx) xb_add(&bar[XB_TOPGEN], 1u);
      else XB_SPIN(xb_ld(&bar[XB_TOPGEN]) == tg, bar);
      __builtin_amdgcn_fence(__ATOMIC_ACQUIRE, "agent");
      xb_add(&bar[XB_XGEN(b.x)], 1u);
      asm volatile("s_waitcnt vmcnt(0)" ::: "memory");
    } else {
      XB_SPIN(xb_ld(&bar[XB_XGEN(b.x)]) == gen, bar);
      __builtin_amdgcn_fence(__ATOMIC_ACQUIRE, "agent");
      asm volatile("s_waitcnt vmcnt(0)" ::: "memory");
    }
  }
  __syncthreads();
}

__device__ __forceinline__ void xcd_barrier_local(const XcdBarrier& b) {
  asm volatile("s_waitcnt vmcnt(0)" ::: "memory");
  __syncthreads();
  if (threadIdx.x == 0) {
    unsigned* bar = b.bar;
    __builtin_amdgcn_s_waitcnt(0);
    unsigned nloc = b.st[0], nx = b.st[1];
    if (nloc == 0u) { xcd_barrier_complete(bar, b.x, nloc, nx); b.st[0] = nloc; b.st[1] = nx; }
    const unsigned old = xb_add(&bar[XB_LSUB(b.x)], 1u);
    const unsigned gen = old / nloc;
    if (old + 1u == (gen + 1u) * nloc) xb_add(&bar[XB_LGEN(b.x)], 1u);
    else XB_SPIN(xb_ld(&bar[XB_LGEN(b.x)]) == gen, bar);
    __builtin_amdgcn_fence(__ATOMIC_ACQUIRE, "agent");
    asm volatile("s_waitcnt vmcnt(0)" ::: "memory");
  }
  __syncthreads();
}

namespace pg8 {
constexpr int BM = 256, BK = 64, HALF = 128, HTB = HALF * BK * 2, STAGE_BYTES = 8 * HTB, NXCD = 8, WGM = 8;
__host__ __device__ __forceinline__ int lds_byte(int r, int c) { const int st = (r >> 4) * 2 + (c >> 5), rr = r & 15, cc = c & 31, ob = rr * 64 + cc * 2; return st * 1024 + (ob ^ (((ob >> 9) & 1) << 5)); }
__host__ __device__ __forceinline__ void stage_rc(int b, int& R, int& C) { const int st = b / 1024, sb = b % 1024, swz = sb ^ (((sb >> 9) & 1) << 5); R = (st >> 1) * 16 + swz / 64; C = (st & 1) * 32 + (swz % 64) / 2; }
struct Unit { int pm, pn; };
struct Gemm { const bf16_t* A; const bf16_t* Bt; int M, N, K; };
__device__ __forceinline__ void map_tile(int L, int nM, int nN, Unit& u) {
  const int nwg = nM * nN; int wgid = L;
  { const int q = nwg / NXCD, r = nwg % NXCD, xcd = wgid % NXCD, off = wgid / NXCD; wgid = (xcd < r ? xcd * (q + 1) : r * (q + 1) + (xcd - r) * q) + off; }
  const int nig = WGM * nN, gid = wgid / nig, fm = gid * WGM, gsz = (nM - fm) < WGM ? (nM - fm) : WGM;
  u.pm = fm + ((wgid % nig) % gsz); u.pn = (wgid % nig) / gsz;
}
struct StaticOrder {
  int nM, nN, nwg, G, c;
  __device__ void init(int M, int N, int G_, int c_) { nM = M / BM; nN = N / BM; nwg = nM * nN; G = G_; c = c_; }
  __device__ bool next(int i, Unit& u) const { const long L = (long)i * G + c; if (L >= nwg || c < 0) return false; map_tile((int)L, nM, nN, u); return true; }
};

__host__ __device__ __forceinline__ int perm32(int rho) { const int n = rho >> 4, i = rho & 15; return 8 * (i >> 2) + 4 * n + (i & 3); }
template <bool PERM = false, class Epi, class Sched>
__device__ __forceinline__ void gemm_phase(LAS unsigned char* lds, const Gemm g, const Sched& S, const Epi& E) {
  const int tid = opaque_tid(), wid = __builtin_amdgcn_readfirstlane(tid >> 6), lane = tid & 63, wr = wid >> 2, wc = wid & 3, fr = lane & 15, fq = lane >> 4;
  const int K = g.K, nt = K / BK;
  unsigned voffA[2], voffB[2];
#pragma unroll
  for (int i = 0; i < 2; ++i) { int R, C; stage_rc(tid * 16 + i * 8192, R, C); const int Rb = PERM ? ((R & ~31) + perm32(R & 31)) : R;
    voffA[i] = (unsigned)(R * K + C) * 2u; voffB[i] = (unsigned)(Rb * K + C) * 2u; }
  const size_t kstep = (size_t)(BK * 2);
  const size_t hstep = (size_t)HALF * K * 2;
  const size_t tstep = 2 * hstep;
  const unsigned ldsw = (unsigned)wid * 1024u;
  const int aoff = lds_byte(wr * 64 + fr, fq * 8), boff = lds_byte(wc * 32 + fr, fq * 8);
#define PG8_SA(b, h) (((b) * 2 + (h)) * HTB)
#define PG8_SB(b, h) ((4 + (b) * 2 + (h)) * HTB)
#define PG8_STAGE(bufoff, gbase, voff) do { _Pragma("unroll") for (int _i = 0; _i < 2; ++_i) \
    __builtin_amdgcn_global_load_lds((const unsigned*)((const char*)(gbase) + (voff)[_i]), (LAS unsigned*)(lds + (bufoff) + ldsw + _i * 8192), 16, 0, 0); } while (0)
#define PG8_LDA(dst, b, h) do { _Pragma("unroll") for (int m = 0; m < 4; ++m) _Pragma("unroll") for (int k = 0; k < 2; ++k) dst[m][k] = *(const LAS bf16x8*)(lds + PG8_SA(b, h) + aoff + m * 2048 + k * 1024); } while (0)
#define PG8_LDB(dst, b, h) do { _Pragma("unroll") for (int n = 0; n < 2; ++n) _Pragma("unroll") for (int k = 0; k < 2; ++k) dst[n][k] = *(const LAS bf16x8*)(lds + PG8_SB(b, h) + boff + n * 2048 + k * 1024); } while (0)
#define PG8_MMA(ai, bj, At, Bt) do { __builtin_amdgcn_s_setprio(1); _Pragma("unroll") for (int m = 0; m < 4; ++m) _Pragma("unroll") for (int n = 0; n < 2; ++n) _Pragma("unroll") for (int k = 0; k < 2; ++k) \
    acc[ai][bj][m][n] = __builtin_amdgcn_mfma_f32_16x16x32_bf16(Bt[n][k], At[m][k], acc[ai][bj][m][n], 0, 0, 0); __builtin_amdgcn_s_setprio(0); } while (0)
#define PG8_WAIT_V(n) asm volatile("s_waitcnt vmcnt(" #n ")" ::: "memory")
#define PG8_WAIT_L(n) asm volatile("s_waitcnt lgkmcnt(" #n ")" ::: "memory")
#define PG8_BAR __builtin_amdgcn_s_barrier()
#define PG8_SCHED __builtin_amdgcn_sched_barrier(0)
  Unit cur, nxt; int ui = 0;
  if (!S.next(0, cur)) return;
  f32x4 acc[2][2][4][2];
#pragma unroll
  for (int a = 0; a < 2; ++a)
#pragma unroll
    for (int b = 0; b < 2; ++b)
#pragma unroll
      for (int m = 0; m < 4; ++m)
#pragma unroll
        for (int n = 0; n < 2; ++n) acc[a][b][m][n] = (f32x4){0.f, 0.f, 0.f, 0.f};
  bf16x8 At[4][2], B0[2][2], B1[2][2];
  const char* cA = (const char*)g.A + (size_t)cur.pm * tstep; const char* cB = (const char*)g.Bt + (size_t)cur.pn * tstep;
  PG8_STAGE(PG8_SB(0, 0), cB, voffB); PG8_STAGE(PG8_SA(0, 0), cA, voffA); PG8_STAGE(PG8_SB(0, 1), cB + hstep, voffB); PG8_STAGE(PG8_SA(0, 1), cA + hstep, voffA);
  if (wr == 1) PG8_BAR;
  PG8_WAIT_V(4); PG8_BAR;
  PG8_STAGE(PG8_SB(1, 0), cB + kstep, voffB); PG8_STAGE(PG8_SA(1, 0), cA + kstep, voffA); PG8_STAGE(PG8_SB(1, 1), cB + hstep + kstep, voffB);
  PG8_WAIT_V(6); PG8_BAR;
  for (;;) {
    const bool has_next = S.next(ui + 1, nxt);
    const char* nA = has_next ? (const char*)g.A + (size_t)nxt.pm * tstep : cA; const char* nB = has_next ? (const char*)g.Bt + (size_t)nxt.pn * tstep : cB;
#pragma unroll 1
    for (int t = 0; t < nt; t += 2) {
      const bool last = (t == nt - 2);
      const char* a1 = cA + (size_t)(t + 1) * kstep;
      const char* a2 = last ? nA : cA + (size_t)(t + 2) * kstep; const char* b2 = last ? nB : cB + (size_t)(t + 2) * kstep;
      const char* a3 = a2 + kstep; const char* b3 = b2 + kstep;
      PG8_LDB(B0, 0, 0); PG8_SCHED; PG8_LDA(At, 0, 0); PG8_STAGE(PG8_SA(1, 1), a1 + hstep, voffA);
      PG8_WAIT_L(8); PG8_BAR; PG8_WAIT_L(0); PG8_MMA(0, 0, At, B0); PG8_BAR; PG8_SCHED;
      PG8_LDB(B1, 0, 1); PG8_STAGE(PG8_SB(0, 0), b2, voffB);
      PG8_BAR; PG8_WAIT_L(0); PG8_MMA(0, 1, At, B1); PG8_BAR;
      PG8_LDA(At, 0, 1); PG8_STAGE(PG8_SA(0, 0), a2, voffA);
      PG8_BAR; PG8_WAIT_L(0); PG8_MMA(1, 0, At, B0); PG8_BAR; PG8_SCHED;
      PG8_STAGE(PG8_SB(0, 1), b2 + hstep, voffB);
      PG8_WAIT_V(6); PG8_BAR; PG8_MMA(1, 1, At, B1); PG8_BAR;
      PG8_LDB(B0, 1, 0); PG8_SCHED; PG8_LDA(At, 1, 0); PG8_STAGE(PG8_SA(0, 1), a2 + hstep, voffA);
      PG8_WAIT_L(8); PG8_BAR; PG8_WAIT_L(0); PG8_MMA(0, 0, At, B0); PG8_BAR; PG8_SCHED;
      PG8_LDB(B1, 1, 1); PG8_STAGE(PG8_SB(1, 0), b3, voffB);
      PG8_BAR; PG8_WAIT_L(0); PG8_MMA(0, 1, At, B1); PG8_BAR;
      PG8_LDA(At, 1, 1); PG8_STAGE(PG8_SA(1, 0), a3, voffA);
      PG8_BAR; PG8_WAIT_L(0); PG8_MMA(1, 0, At, B0); PG8_BAR; PG8_SCHED;
      PG8_STAGE(PG8_SB(1, 1), b3 + hstep, voffB);
      PG8_WAIT_V(6); PG8_BAR; PG8_MMA(1, 1, At, B1); PG8_BAR;
    }
    E(acc, cur, wr, wc, fr, fq);
    if (!has_next) break;
#pragma unroll
    for (int a = 0; a < 2; ++a)
#pragma unroll
      for (int b = 0; b < 2; ++b)
#pragma unroll
        for (int m = 0; m < 4; ++m)
#pragma unroll
          for (int n = 0; n < 2; ++n) acc[a][b][m][n] = (f32x4){0.f, 0.f, 0.f, 0.f};
    cur = nxt; cA = nA; cB = nB; ++ui;
  }
  PG8_WAIT_V(0);
  if (wr == 0) PG8_BAR;
  PG8_BAR;
#undef PG8_SA
#undef PG8_SB
#undef PG8_STAGE
#undef PG8_LDA
#undef PG8_LDB
#undef PG8_MMA
#undef PG8_WAIT_V
#undef PG8_WAIT_L
#undef PG8_BAR
#undef PG8_SCHED
}
}
using pg8::Unit;

#define EPI_ROWS(...) _Pragma("unroll") for (int ai = 0; ai < 2; ++ai) _Pragma("unroll") for (int m = 0; m < 4; ++m) { const int row = u.pm * 256 + ai * 128 + wr * 64 + m * 16 + fr; __VA_ARGS__ }

__device__ __forceinline__ f32x4 load_bf4(const bf16_t* p) { const u32x2 w = *(const u32x2*)p; f32x4 v; v[0] = __uint_as_float(w.x << 16); v[1] = __uint_as_float(w.x & 0xffff0000u); v[2] = __uint_as_float(w.y << 16); v[3] = __uint_as_float(w.y & 0xffff0000u); return v; }
__device__ __forceinline__ void store_bf4(bf16_t* p, f32x4 v) { u32x2 w; w.x = cvt_pk_bf16(v[0], v[1]); w.y = cvt_pk_bf16(v[2], v[3]); *(u32x2*)p = w; }
__device__ __forceinline__ int vt_pos(int w) { return 8 * ((w >> 2) & 1) + 4 * (w >> 3) + (w & 3); }

__device__ __forceinline__ void load_bf8(const bf16_t* p, f32x4& a, f32x4& b) { const u32x4 w = *(const u32x4*)p;
  a[0] = __uint_as_float(w.x << 16); a[1] = __uint_as_float(w.x & 0xffff0000u); a[2] = __uint_as_float(w.y << 16); a[3] = __uint_as_float(w.y & 0xffff0000u);
  b[0] = __uint_as_float(w.z << 16); b[1] = __uint_as_float(w.z & 0xffff0000u); b[2] = __uint_as_float(w.w << 16); b[3] = __uint_as_float(w.w & 0xffff0000u); }
__device__ __forceinline__ void store_bf8(bf16_t* p, const f32x4& a, const f32x4& b) { u32x4 w; w.x = cvt_pk_bf16(a[0], a[1]); w.y = cvt_pk_bf16(a[2], a[3]); w.z = cvt_pk_bf16(b[0], b[1]); w.w = cvt_pk_bf16(b[2], b[3]); *(u32x4*)p = w; }
struct EpiGU {
  const float* ssq; bf16_t* act;
  __device__ __forceinline__ void operator()(const f32x4 (&acc)[2][2][4][2], const Unit& u, int wr, int wc, int fr, int fq) const {
    EPI_ROWS(
      const float rs = rsqrtf(sum16(ssq + (size_t)row * 16) * (1.0f / D) + EPS);
      f32x4 o[2];
      _Pragma("unroll") for (int n = 0; n < 2; ++n) {
        const f32x4 g = acc[ai][0][m][n] * rs, v = acc[ai][1][m][n] * rs;
        _Pragma("unroll") for (int j = 0; j < 4; ++j) o[n][j] = g[j] * frcp(1.0f + fexp2(-g[j] * LOG2E)) * v[j]; }
      store_bf8(act + (size_t)row * FF + u.pn * 128 + wc * 32 + fq * 8, o[0], o[1]);
    )
  }
};
struct EpiRes {
  const float* rin_f; const bf16_t* rin_b; bf16_t* hb; float* ssq_out; float scale;
  __device__ __forceinline__ void operator()(const f32x4 (&acc)[2][2][4][2], const Unit& u, int wr, int wc, int fr, int fq) const {
    EPI_ROWS(
      const size_t off = (size_t)row * D + u.pn * 256 + wc * 32 + fq * 4; float sq = 0.f;
      _Pragma("unroll") for (int bj = 0; bj < 2; ++bj) _Pragma("unroll") for (int n = 0; n < 2; ++n) {
        const size_t o2 = off + bj * 128 + n * 16;
        f32x4 hv = rin_f ? *(const f32x4*)(rin_f + o2) : load_bf4(rin_b + o2); hv += acc[ai][bj][m][n] * scale;
        store_bf4(hb + o2, hv);
        sq += hv[0] * hv[0] + hv[1] * hv[1] + hv[2] * hv[2] + hv[3] * hv[3]; }
      sq += __shfl_xor(sq, 16); sq += __shfl_xor(sq, 32);
      if (fq == 0) ssq_out[(size_t)row * 16 + u.pn * 4 + wc] = sq;
    )
  }
};
struct EpiPle {
  const float* ssq_in; const bf16_t* proj; const bf16_t* rin; bf16_t* hb; float* ssq_out;
  __device__ __forceinline__ void operator()(const f32x4 (&acc)[2][2][4][2], const Unit& u, int wr, int wc, int fr, int fq) const {
    EPI_ROWS(
      const float rs = rsqrtf(sum16(ssq_in + (size_t)row * 16) * (1.0f / D) + EPS);
      const size_t off = (size_t)row * D + u.pn * 256 + wc * 32 + fq * 4; float sq = 0.f;
      _Pragma("unroll") for (int bj = 0; bj < 2; ++bj) _Pragma("unroll") for (int n = 0; n < 2; ++n) {
        const size_t o2 = off + bj * 128 + n * 16;
        f32x4 hv = load_bf4(rin + o2); const f32x4 pr = load_bf4(proj + o2);
        _Pragma("unroll") for (int j = 0; j < 4; ++j) { const float gt = frcp(1.0f + fexp2(-acc[ai][bj][m][n][j] * rs * LOG2E)); hv[j] += pr[j] * gt; }
        store_bf4(hb + o2, hv);
        sq += hv[0] * hv[0] + hv[1] * hv[1] + hv[2] * hv[2] + hv[3] * hv[3]; }
      sq += __shfl_xor(sq, 16); sq += __shfl_xor(sq, 32);
      if (fq == 0) ssq_out[(size_t)row * 16 + u.pn * 4 + wc] = sq;
    )
  }
};
__device__ __forceinline__ void unpack_bf8(const u32x4& w, f32x4& a, f32x4& b) {
  a[0] = __uint_as_float(w.x << 16); a[1] = __uint_as_float(w.x & 0xffff0000u); a[2] = __uint_as_float(w.y << 16); a[3] = __uint_as_float(w.y & 0xffff0000u);
  b[0] = __uint_as_float(w.z << 16); b[1] = __uint_as_float(w.z & 0xffff0000u); b[2] = __uint_as_float(w.w << 16); b[3] = __uint_as_float(w.w & 0xffff0000u); }
struct EpiResP {
  const float* rin_f; const bf16_t* rin_b; bf16_t* hb; float* ssq_out; float scale;
  __device__ __forceinline__ void operator()(const f32x4 (&acc)[2][2][4][2], const Unit& u, int wr, int wc, int fr, int fq) const {
    _Pragma("unroll") for (int ai = 0; ai < 2; ++ai) {
      const size_t off0 = (size_t)(u.pm * 256 + ai * 128 + wr * 64 + fr) * D + u.pn * 256 + wc * 32 + fq * 8;
      f32x4 h0[4][2]; f32x4 h1[4][2];
      if (rin_f) {
        _Pragma("unroll") for (int m = 0; m < 4; ++m) _Pragma("unroll") for (int bj = 0; bj < 2; ++bj) {
          const size_t o2 = off0 + (size_t)m * 16 * D + bj * 128; h0[m][bj] = *(const f32x4*)(rin_f + o2); h1[m][bj] = *(const f32x4*)(rin_f + o2 + 4); }
      } else {
        u32x4 w[4][2];
        _Pragma("unroll") for (int m = 0; m < 4; ++m) _Pragma("unroll") for (int bj = 0; bj < 2; ++bj) w[m][bj] = *(const u32x4*)(rin_b + off0 + (size_t)m * 16 * D + bj * 128);
        _Pragma("unroll") for (int m = 0; m < 4; ++m) _Pragma("unroll") for (int bj = 0; bj < 2; ++bj) unpack_bf8(w[m][bj], h0[m][bj], h1[m][bj]);
      }
      _Pragma("unroll") for (int m = 0; m < 4; ++m) {
        const int row = u.pm * 256 + ai * 128 + wr * 64 + m * 16 + fr; float sq = 0.f;
        _Pragma("unroll") for (int bj = 0; bj < 2; ++bj) {
          f32x4 a = h0[m][bj] + acc[ai][bj][m][0] * scale, b = h1[m][bj] + acc[ai][bj][m][1] * scale;
          store_bf8(hb + off0 + (size_t)m * 16 * D + bj * 128, a, b);
          sq += (a[0] * a[0] + a[1] * a[1] + a[2] * a[2] + a[3] * a[3]) + (b[0] * b[0] + b[1] * b[1] + b[2] * b[2] + b[3] * b[3]); }
        sq += __shfl_xor(sq, 16); sq += __shfl_xor(sq, 32);
        if (fq == 0) ssq_out[(size_t)row * 16 + u.pn * 4 + wc] = sq;
      }
    }
  }
};
struct EpiPleP {
  const float* ssq_in; const bf16_t* proj; const bf16_t* rin; bf16_t* hb; float* ssq_out;
  __device__ __forceinline__ void operator()(const f32x4 (&acc)[2][2][4][2], const Unit& u, int wr, int wc, int fr, int fq) const {
    _Pragma("unroll") for (int ai = 0; ai < 2; ++ai) {
      const size_t off0 = (size_t)(u.pm * 256 + ai * 128 + wr * 64 + fr) * D + u.pn * 256 + wc * 32 + fq * 8;
      u32x4 wr_[4][2]; u32x4 wp[4][2];
      _Pragma("unroll") for (int m = 0; m < 4; ++m) _Pragma("unroll") for (int bj = 0; bj < 2; ++bj) {
        const size_t o2 = off0 + (size_t)m * 16 * D + bj * 128; wr_[m][bj] = *(const u32x4*)(rin + o2); wp[m][bj] = *(const u32x4*)(proj + o2); }
      _Pragma("unroll") for (int m = 0; m < 4; ++m) {
        const int row = u.pm * 256 + ai * 128 + wr * 64 + m * 16 + fr; float sq = 0.f;
        const float rs = rsqrtf(sum16(ssq_in + (size_t)row * 16) * (1.0f / D) + EPS);
        _Pragma("unroll") for (int bj = 0; bj < 2; ++bj) {
          f32x4 h0; f32x4 h1; f32x4 p0; f32x4 p1; unpack_bf8(wr_[m][bj], h0, h1); unpack_bf8(wp[m][bj], p0, p1);
          _Pragma("unroll") for (int j = 0; j < 4; ++j) {
            h0[j] += p0[j] * frcp(1.0f + fexp2(-acc[ai][bj][m][0][j] * rs * LOG2E));
            h1[j] += p1[j] * frcp(1.0f + fexp2(-acc[ai][bj][m][1][j] * rs * LOG2E)); }
          store_bf8(hb + off0 + (size_t)m * 16 * D + bj * 128, h0, h1);
          sq += (h0[0] * h0[0] + h0[1] * h0[1] + h0[2] * h0[2] + h0[3] * h0[3]) + (h1[0] * h1[0] + h1[1] * h1[1] + h1[2] * h1[2] + h1[3] * h1[3]); }
        sq += __shfl_xor(sq, 16); sq += __shfl_xor(sq, 32);
        if (fq == 0) ssq_out[(size_t)row * 16 + u.pn * 4 + wc] = sq;
      }
    }
  }
};
struct EpiProj {
  bf16_t* proj;
  __device__ __forceinline__ void operator()(const f32x4 (&acc)[2][2][4][2], const Unit& u, int wr, int wc, int fr, int fq) const {
    EPI_ROWS(
      const size_t off = (size_t)row * D + u.pn * 256 + wc * 32 + fq * 4;
      _Pragma("unroll") for (int bj = 0; bj < 2; ++bj) _Pragma("unroll") for (int n = 0; n < 2; ++n) store_bf4(proj + off + bj * 128 + n * 16, acc[ai][bj][m][n]);
    )
  }
};
struct EpiWin {
  const float* ssq_in; bf16_t* qkv; bf16_t* cq; bf16_t* ckv; bf16_t* vtsb; bf16_t* vtdf; float* ssqq; float* ssqkv; const float* cosd; const float* sind;
  __device__ __forceinline__ void operator()(const f32x4 (&acc)[2][2][4][2], const Unit& u, int wr, int wc, int fr, int fq) const {
    const int pn = u.pn;
    EPI_ROWS(
      const float rs = rsqrtf(sum16(ssq_in + (size_t)row * 16) * (1.0f / D) + EPS);
      if (pn == 2 || pn == 7 || pn == 8) {
        const int b = row >> 12, s = row & 4095, pos = (s & ~15) + vt_pos(s & 15);
        _Pragma("unroll") for (int bj = 0; bj < 2; ++bj) _Pragma("unroll") for (int n = 0; n < 2; ++n) {
          const int c = pn * 256 + bj * 128 + wc * 32 + n * 16 + fq * 4; const f32x4 v = acc[ai][bj][m][n] * rs;
          bf16_t* base;
          if (pn == 2) { const int cc = c - 512; base = vtsb + ((size_t)((b * 4 + (cc >> 6)) * 64 + (cc & 63))) * SEQ + pos; }
          else { const int cc = c - 1792; base = vtdf + ((size_t)((b * 4 + (cc >> 7)) * 128 + (cc & 127))) * SEQ + pos; }
          _Pragma("unroll") for (int j = 0; j < 4; ++j) base[(size_t)j * SEQ] = f2bf(v[j]);
        }
      } else if (pn >= 9) {
        bf16_t* dst = (pn == 9 ? cq : ckv) + (size_t)row * 256 + wc * 32 + fq * 4; float sq = 0.f;
        _Pragma("unroll") for (int bj = 0; bj < 2; ++bj) _Pragma("unroll") for (int n = 0; n < 2; ++n) {
          const f32x4 v = acc[ai][bj][m][n] * rs; store_bf4(dst + bj * 128 + n * 16, v);
          if (pn == 9 || bj == 0) sq += v[0] * v[0] + v[1] * v[1] + v[2] * v[2] + v[3] * v[3]; }
        sq += __shfl_xor(sq, 16); sq += __shfl_xor(sq, 32);
        if (fq == 0) (pn == 9 ? ssqq : ssqkv)[(size_t)row * 4 + wc] = sq;
      } else {
        bf16_t* dst = qkv + (size_t)row * QW + pn * 256 + wc * 32 + fq * 4;
        const bool rot = pn >= 3 && pn <= 6 && (wc & 1) == 0;
        f32x4 cs4 = {1.f, 1.f, 1.f, 1.f}, sn4 = {0.f, 0.f, 0.f, 0.f};
        if (rot) { cs4 = *(const f32x4*)(cosd + (size_t)row * 8 + (fq & 1) * 4); sn4 = *(const f32x4*)(sind + (size_t)row * 8 + (fq & 1) * 4); if (fq < 2) sn4 = -sn4; }
        _Pragma("unroll") for (int bj = 0; bj < 2; ++bj) _Pragma("unroll") for (int n = 0; n < 2; ++n) {
          f32x4 v = acc[ai][bj][m][n] * rs;
          if (n == 0 && rot) { f32x4 pr; _Pragma("unroll") for (int j = 0; j < 4; ++j) pr[j] = __shfl_xor(v[j], 32); v = v * cs4 + pr * sn4; }
          store_bf4(dst + bj * 128 + n * 16, v);
        }
      }
    )
  }
};
struct EpiUpQ {
  const float* ssqq; bf16_t* qm; const float* cosm; const float* sinm;
  __device__ __forceinline__ void operator()(const f32x4 (&acc)[2][2][4][2], const Unit& u, int wr, int wc, int fr, int fq) const {
    EPI_ROWS(
      const float rs = rsqrtf(sum4(ssqq + (size_t)row * 4) * (1.0f / 256) + EPS);
      _Pragma("unroll") for (int bj = 0; bj < 2; ++bj) {
        const int G = u.pn * 8 + bj * 4 + wc;
        if (G < 12) {
          bf16_t* dst = qm + (size_t)row * 384 + G * 32 + fq * 4;
          f32x4 x1 = acc[ai][bj][m][0] * rs, x2 = acc[ai][bj][m][1] * rs;
          if (G % 3 == 2) {
            const f32x4 c = *(const f32x4*)(cosm + (size_t)row * 16 + fq * 4), s = *(const f32x4*)(sinm + (size_t)row * 16 + fq * 4);
            const f32x4 o1 = x1 * c - x2 * s, o2 = x2 * c + x1 * s; x1 = o1; x2 = o2;
          }
          store_bf4(dst, x1); store_bf4(dst + 16, x2);
        }
      }
    )
  }
};
struct EpiUpKV {
  const float* ssqkv; bf16_t* km; bf16_t* vtml;
  __device__ __forceinline__ void operator()(const f32x4 (&acc)[2][2][4][2], const Unit& u, int wr, int wc, int fr, int fq) const {
    EPI_ROWS(
      const float rs = rsqrtf(sum4(ssqkv + (size_t)row * 4) * (1.0f / 128) + EPS);
      const int b = row >> 12, s = row & 4095, pos = (s & ~15) + vt_pos(s & 15);
      _Pragma("unroll") for (int bj = 0; bj < 2; ++bj) _Pragma("unroll") for (int n = 0; n < 2; ++n) {
        const int c = bj * 128 + wc * 32 + n * 16 + fq * 4; const f32x4 v = acc[ai][bj][m][n] * rs;
        if (u.pn == 0) store_bf4(km + (size_t)row * 384 + (c >> 6) * 96 + (c & 63), v);
        else { bf16_t* base = vtml + ((size_t)((b * 4 + (c >> 6)) * 64 + (c & 63))) * SEQ + pos;
          _Pragma("unroll") for (int j = 0; j < 4; ++j) base[(size_t)j * SEQ] = f2bf(v[j]); }
      }
    )
  }
};

constexpr int LDS_K = 0, LDS_V = 16384;

template <int DQK, int DV, bool SB>
__device__ __forceinline__ void attn_pass(LAS unsigned char* lds, const bf16_t* Qg, int ldq, const bf16_t* Kg, int ldk, const bf16_t* VTg, int q0, float sc,
                                          f32x16 (&o)[DV / 32], float& lsum) {
  constexpr int KS = (DQK + 8) * 2, VS = 144, CK = DQK / 8, NKL = (64 * CK + 511) / 512, NVL = DV / 64, NKK = DQK / 16;
  const int tid = opaque_tid(), wid = tid >> 6, lane = tid & 63, l31 = lane & 31, hh = lane >> 5;
  const int qrow = q0 + wid * 32 + l31, qmin = q0 + wid * 32, qmax = qmin + 31;
  bf16x8 qf[NKK];
#pragma unroll
  for (int kk = 0; kk < NKK; ++kk) qf[kk] = *(const bf16x8*)(Qg + (size_t)qrow * ldq + kk * 16 + hh * 8);
#pragma unroll
  for (int db = 0; db < DV / 32; ++db)
#pragma unroll
    for (int r = 0; r < 16; ++r) o[db][r] = 0.f;
  float mrun = -INFINITY, lrun = 0.f, carry = 0.f;
  const int nt = (q0 + 256) / 64;
  u32x4 kreg[NKL], vreg[NVL];
  auto gload = [&](int k0) {
#pragma unroll
    for (int i = 0; i < NKL; ++i) { const int idx = tid + i * 512; if (idx < 64 * CK) { const int row = idx / CK, ch = idx % CK; kreg[i] = *(const u32x4*)(Kg + (size_t)(k0 + row) * ldk + ch * 8); } }
#pragma unroll
    for (int i = 0; i < NVL; ++i) { const int idx = tid + i * 512; const int d = idx >> 3, ch = idx & 7; vreg[i] = *(const u32x4*)(VTg + (size_t)d * SEQ + k0 + ch * 8); }
  };
  gload(SB ? (nt - 1) * 64 : 0);
  for (int it = 0; it < nt; ++it) {
    const int k0 = (SB ? (nt - 1 - it) : it) * 64;
    if (SB) {
      const bool wdone = (k0 + 64 <= qmax) && __all(carry < -110.0f);
      if (__syncthreads_and(wdone)) break;
    } else __syncthreads();
#pragma unroll
    for (int i = 0; i < NKL; ++i) { const int idx = tid + i * 512; if (idx < 64 * CK) { const int row = idx / CK, ch = idx % CK; *(LAS u32x4*)(lds + LDS_K + row * KS + ch * 16) = kreg[i]; } }
#pragma unroll
    for (int i = 0; i < NVL; ++i) { const int idx = tid + i * 512; const int d = idx >> 3, ch = idx & 7; *(LAS u32x4*)(lds + LDS_V + d * VS + ch * 16) = vreg[i]; }
    __syncthreads();
    if (it + 1 < nt) gload((SB ? (nt - 2 - it) : (it + 1)) * 64);
    if (k0 <= qmax) {
      f32x16 s[2];
#pragma unroll
      for (int kb = 0; kb < 2; ++kb) {
#pragma unroll
        for (int r = 0; r < 16; ++r) s[kb][r] = 0.f;
#pragma unroll
        for (int kk = 0; kk < NKK; ++kk) {
          const bf16x8 a = *(const LAS bf16x8*)(lds + LDS_K + (kb * 32 + l31) * KS + (kk * 16 + hh * 8) * 2);
          s[kb] = __builtin_amdgcn_mfma_f32_32x32x16_bf16(a, qf[kk], s[kb], 0, 0, 0);
        }
      }
      const bool diag = (k0 + 63 >= qmin);
      if (!SB) {
        float mx = -INFINITY;
        if (diag) {
#pragma unroll
          for (int kb = 0; kb < 2; ++kb)
#pragma unroll
            for (int r = 0; r < 16; ++r) { const int key = k0 + kb * 32 + 8 * (r >> 2) + 4 * hh + (r & 3); if (key > qrow) s[kb][r] = -INFINITY; }
        }
#pragma unroll
        for (int kb = 0; kb < 2; ++kb)
#pragma unroll
          for (int r = 0; r < 16; ++r) mx = fmaxf(mx, s[kb][r]);
        mx = fmaxf(mx, __shfl_xor(mx, 32));
        const float mnew = fmaxf(mrun, mx);
        if (!__all(mnew == mrun)) {
          const float alpha = fexp2((mrun - mnew) * sc);
          lrun *= alpha;
#pragma unroll
          for (int db = 0; db < DV / 32; ++db)
#pragma unroll
            for (int r = 0; r < 16; ++r) o[db][r] *= alpha;
          mrun = mnew;
        }
        const float msc = -mnew * sc;
#pragma unroll
        for (int kb = 0; kb < 2; ++kb)
#pragma unroll
          for (int r = 0; r < 16; ++r) { const float pv = fexp2(__builtin_fmaf(s[kb][r], sc, msc)); s[kb][r] = pv; lrun += pv; }
      } else {
        float lk[2][16];
#pragma unroll
        for (int kb = 0; kb < 2; ++kb)
#pragma unroll
          for (int r = 0; r < 16; ++r) {
            const float z = s[kb][r] * sc;
            const float e = fexp2(-fabsf(z) * LOG2E);
            const float lb = fminf(z, 0.f) - flog2(1.0f + e) * LN2;
            bool valid = true;
            if (diag) { const int key = k0 + kb * 32 + 8 * (r >> 2) + 4 * hh + (r & 3); valid = key < qrow; }
            s[kb][r] = valid ? lb : -INFINITY; lk[kb][r] = valid ? lb - z : 0.f;
          }
        float run = carry;
#pragma unroll
        for (int kb = 1; kb >= 0; --kb)
#pragma unroll
          for (int g = 3; g >= 0; --g) {
            const float G = (lk[kb][4 * g] + lk[kb][4 * g + 1]) + (lk[kb][4 * g + 2] + lk[kb][4 * g + 3]);
            const float Gp = __shfl_xor(G, 32);
            float bt = run + (hh == 0 ? Gp : 0.f);
            s[kb][4 * g + 3] = fexp2((s[kb][4 * g + 3] + bt) * LOG2E); bt += lk[kb][4 * g + 3];
            s[kb][4 * g + 2] = fexp2((s[kb][4 * g + 2] + bt) * LOG2E); bt += lk[kb][4 * g + 2];
            s[kb][4 * g + 1] = fexp2((s[kb][4 * g + 1] + bt) * LOG2E); bt += lk[kb][4 * g + 1];
            s[kb][4 * g + 0] = fexp2((s[kb][4 * g + 0] + bt) * LOG2E);
            run += G + Gp;
          }
        carry = run;
      }
#pragma unroll
      for (int kb = 0; kb < 2; ++kb)
#pragma unroll
        for (int s2 = 0; s2 < 2; ++s2) {
          u32x4 pw;
          pw.x = cvt_pk_bf16(s[kb][8 * s2 + 0], s[kb][8 * s2 + 1]); pw.y = cvt_pk_bf16(s[kb][8 * s2 + 2], s[kb][8 * s2 + 3]);
          pw.z = cvt_pk_bf16(s[kb][8 * s2 + 4], s[kb][8 * s2 + 5]); pw.w = cvt_pk_bf16(s[kb][8 * s2 + 6], s[kb][8 * s2 + 7]);
          const bf16x8 pf = __builtin_bit_cast(bf16x8, pw);
#pragma unroll
          for (int db = 0; db < DV / 32; ++db) {
            const bf16x8 a = *(const LAS bf16x8*)(lds + LDS_V + (db * 32 + l31) * VS + (kb * 32 + s2 * 16 + hh * 8) * 2);
            o[db] = __builtin_amdgcn_mfma_f32_32x32x16_bf16(a, pf, o[db], 0, 0, 0);
          }
        }
    }
  }
  lsum = lrun + __shfl_xor(lrun, 32);
}

constexpr int LDS_OUT = 49152;
template <int NDB>
__device__ __forceinline__ void attn_store(LAS unsigned char* lds, bf16_t* mixed, int tok0w, int col0, const f32x16 (&o)[NDB], int wid, int lane) {
  constexpr int RS = NDB * 64 + 16, CPR = NDB * 4;
  LAS unsigned char* reg = lds + LDS_OUT + wid * (32 * 272);
  const int l31 = lane & 31, hh = lane >> 5;
#pragma unroll
  for (int db = 0; db < NDB; ++db)
#pragma unroll
    for (int g = 0; g < 4; ++g) {
      u32x2 w; w.x = cvt_pk_bf16(o[db][4 * g], o[db][4 * g + 1]); w.y = cvt_pk_bf16(o[db][4 * g + 2], o[db][4 * g + 3]);
      *(LAS u32x2*)(reg + l31 * RS + (db * 32 + 8 * g + 4 * hh) * 2) = w;
    }
  asm volatile("s_waitcnt lgkmcnt(0)" ::: "memory");
#pragma unroll
  for (int i = 0; i < 32 * CPR / 64; ++i) {
    const int idx = i * 64 + lane, row = idx / CPR, ch = idx % CPR;
    const u32x4 w = *(const LAS u32x4*)(reg + row * RS + ch * 16);
    *(u32x4*)(mixed + (size_t)(tok0w + row) * D + col0 + ch * 8) = w;
  }
}

__device__ const unsigned char ATT_ORDER[48] = {
  31, 30, 29, 28, 27, 26, 25, 24, 23, 22, 21, 20, 19, 18, 15, 14, 13, 12, 11, 10, 9, 8, 7, 6, 5, 4, 3, 2, 17, 1, 16, 0, 47, 46, 45, 44, 43, 42, 41, 40, 39, 38, 37, 36, 35, 34, 33, 32
};

__device__ __forceinline__ void attn_phase(const Params& p, int layer, LAS unsigned char* lds, int* ctr, unsigned* up_done) {
  bool mla_ready = false;
  LAS int* slot = (LAS int*)(lds + 40960);
  for (;;) {
    unsigned char* ws = opq(p.ws);
    const bf16_t* qkv = (const bf16_t*)(ws + WS_QKV);
    bf16_t* mixed = (bf16_t*)(ws + WS_MIX);
    const int tid = opaque_tid(), wid = tid >> 6, lane = tid & 63, l31 = lane & 31, hh = lane >> 5;
    __syncthreads();
    if (tid == 0) *slot = atomicAdd(ctr, 1);
    __syncthreads();
    const int item = *slot;
    if (item >= 768) break;
    const int e = ATT_ORDER[item >> 4], type = e >> 4, qb = e & 15, bh = item & 15, b = bh >> 2, head = bh & 3;
    const int q0 = qb * 256, tok = b * SEQ + q0 + wid * 32 + l31;
    if (type == 2 && !mla_ready) {
      if (tid == 0) { unsigned sp = 0;
        while (__hip_atomic_load(up_done, __ATOMIC_RELAXED, __HIP_MEMORY_SCOPE_AGENT) < gridDim.x) { __builtin_amdgcn_s_sleep(2); if (++sp > (1u << 22)) break; }
        __builtin_amdgcn_fence(__ATOMIC_ACQUIRE, "agent"); asm volatile("s_waitcnt vmcnt(0)" ::: "memory"); }
      __syncthreads();
      mla_ready = true;
    }
    if (type == 0) {
      f32x16 o[2]; float l;
      attn_pass<64, 64, true>(lds, qkv + (size_t)b * SEQ * QW + head * 64, QW, qkv + (size_t)b * SEQ * QW + 256 + head * 64, QW,
                              (const bf16_t*)(ws + WS_VTSB) + (size_t)bh * 64 * SEQ, q0, 0.125f, o, l);
      attn_store<2>(lds, mixed, tok - l31, head * 64, o, wid, lane);
    } else if (type == 1) {
      const float* lq1 = p.in[12] + layer * 64; const float* lk1 = p.in[13] + layer * 64; const float* lq2 = p.in[14] + layer * 64; const float* lk2 = p.in[15] + layer * 64;
      const float linit = 0.8f - 0.6f * expf(-0.3f * (float)layer);
      const float lam = expf(wave_sum(lq1[lane] * lk1[lane])) - expf(wave_sum(lq2[lane] * lk2[lane])) + linit;
      f32x16 o1[4]; float l1, l2;
      const bf16_t* vt = (const bf16_t*)(ws + WS_VTDF) + (size_t)bh * 128 * SEQ;
      f32x4* stash = (f32x4*)(ws + WS_STASH) + (size_t)blockIdx.x * 16 * 512 + tid;
      attn_pass<64, 128, false>(lds, qkv + (size_t)b * SEQ * QW + 768 + head * 128, QW, qkv + (size_t)b * SEQ * QW + 1280 + head * 128, QW, vt, q0, 0.125f * LOG2E, o1, l1);
      { const float inv = 1.0f / l1;
#pragma unroll
        for (int db = 0; db < 4; ++db)
#pragma unroll
          for (int g = 0; g < 4; ++g) { f32x4 v; v[0] = o1[db][4 * g] * inv; v[1] = o1[db][4 * g + 1] * inv; v[2] = o1[db][4 * g + 2] * inv; v[3] = o1[db][4 * g + 3] * inv; stash[(db * 4 + g) * 512] = v; } }
      attn_pass<64, 128, false>(lds, qkv + (size_t)b * SEQ * QW + 768 + head * 128 + 64, QW, qkv + (size_t)b * SEQ * QW + 1280 + head * 128 + 64, QW, vt, q0, 0.125f * LOG2E, o1, l2);
      { const float inv = lam / l2; float sq = 0.f;
#pragma unroll
        for (int db = 0; db < 4; ++db)
#pragma unroll
          for (int g = 0; g < 4; ++g) { const f32x4 a = stash[(db * 4 + g) * 512];
#pragma unroll
            for (int j = 0; j < 4; ++j) { const float v = a[j] - o1[db][4 * g + j] * inv; o1[db][4 * g + j] = v; sq += v * v; } }
        sq += __shfl_xor(sq, 32);
        const float rs = rsqrtf(sq * (1.0f / 128) + EPS) * (1.0f - linit);
        const float* gsub = p.in[16] + layer * 128;
#pragma unroll
        for (int db = 0; db < 4; ++db)
#pragma unroll
          for (int g = 0; g < 4; ++g) { const f32x4 gv = *(const f32x4*)(gsub + db * 32 + 8 * g + 4 * hh);
#pragma unroll
            for (int j = 0; j < 4; ++j) o1[db][4 * g + j] *= rs * gv[j]; } }
      attn_store<4>(lds, mixed, tok - l31, 256 + head * 128, o1, wid, lane);
    } else {
      f32x16 o[2]; float l;
      attn_pass<96, 64, false>(lds, (const bf16_t*)(ws + WS_QM) + (size_t)b * SEQ * 384 + head * 96, 384, (const bf16_t*)(ws + WS_KM) + (size_t)b * SEQ * 384 + head * 96, 384,
                               (const bf16_t*)(ws + WS_VTML) + (size_t)bh * 64 * SEQ, q0, 0.10206207261596577f * LOG2E, o, l);
      const float inv = 1.0f / l;
#pragma unroll
      for (int db = 0; db < 2; ++db)
#pragma unroll
        for (int r = 0; r < 16; ++r) o[db][r] *= inv;
      attn_store<2>(lds, mixed, tok - l31, 768 + head * 64, o, wid, lane);
    }
  }
}

struct WDesc { const float* src; bf16_t* dst; const float* gain; int K, Kpad, Nsrc, Npad, mode; };
__device__ __forceinline__ void get_wdesc(const Params& p, int layer, int kind, WDesc& d) {
  unsigned char* wl = p.ws + WS_W + (size_t)layer * SZ_WL;
  d.gain = nullptr; d.mode = 0;
  switch (kind) {
    case 0: d.src = p.in[4] + (size_t)layer * D * GU; d.dst = (bf16_t*)(wl + WO_GU1); d.gain = p.in[3] + layer * D; d.K = D; d.Kpad = D; d.Nsrc = GU; d.Npad = GU; d.mode = 1; break;
    case 1: d.src = p.in[5] + (size_t)layer * FF * D; d.dst = (bf16_t*)(wl + WO_D1); d.K = FF; d.Kpad = FF; d.Nsrc = D; d.Npad = D; break;
    case 2: d.src = p.in[7] + (size_t)layer * D * 2720; d.dst = (bf16_t*)(wl + WO_IN); d.gain = p.in[6] + layer * D; d.K = D; d.Kpad = D; d.Nsrc = 2720; d.Npad = NQ; break;
    case 3: d.src = p.in[9] + (size_t)layer * 256 * 384; d.dst = (bf16_t*)(wl + WO_UPQ); d.gain = p.in[8] + layer * 256; d.K = 256; d.Kpad = 256; d.Nsrc = 384; d.Npad = 512; break;
    case 4: d.src = p.in[11] + (size_t)layer * 128 * 512; d.dst = (bf16_t*)(wl + WO_UPKV); d.gain = p.in[10] + layer * 128; d.K = 128; d.Kpad = 256; d.Nsrc = 512; d.Npad = 512; d.mode = 2; break;
    case 5: d.src = p.in[17] + (size_t)layer * D * D; d.dst = (bf16_t*)(wl + WO_OUT); d.K = D; d.Kpad = D; d.Nsrc = D; d.Npad = D; break;
    case 6: d.src = p.in[19] + (size_t)layer * D * GU; d.dst = (bf16_t*)(wl + WO_GU2); d.gain = p.in[18] + layer * D; d.K = D; d.Kpad = D; d.Nsrc = GU; d.Npad = GU; d.mode = 1; break;
    case 7: d.src = p.in[20] + (size_t)layer * FF * D; d.dst = (bf16_t*)(wl + WO_D2); d.K = FF; d.Kpad = FF; d.Nsrc = D; d.Npad = D; break;
    case 8: d.src = p.in[22] + (size_t)layer * D * D; d.dst = (bf16_t*)(wl + WO_GATE); d.gain = p.in[21] + layer * D; d.K = D; d.Kpad = D; d.Nsrc = D; d.Npad = D; break;
    default: d.src = p.in[23] + (size_t)layer * 256 * D; d.dst = (bf16_t*)(wl + WO_PJ); d.K = 256; d.Kpad = 256; d.Nsrc = D; d.Npad = D; break;
  }
}
__device__ __forceinline__ int wsrc_col(int mode, int n, int Nsrc) {
  if (mode == 1) return ((n >> 7) & 1) * FF + (n >> 8) * 128 + (n & 127);
  if (mode == 2) return n < 256 ? (n >> 6) * 128 + (n & 63) : ((n - 256) >> 6) * 128 + 64 + (n & 63);
  return n < Nsrc ? n : -1;
}

__device__ __forceinline__ void prologue(const Params& p, LAS unsigned char* lds) {
  const int tid = opaque_tid(), nb = gridDim.x, bid = blockIdx.x;
  unsigned char* ws = p.ws;
  if (bid == 0 && tid < 64) ((int*)(ws + WS_CTR))[tid] = 0;
  { float* cosd = (float*)(ws + WS_ROPE); float* sind = cosd + T * 8; float* cosm = sind + T * 8; float* sinm = cosm + T * 16;
    const int* pos = (const int*)p.in[2];
    for (int i = bid * 512 + tid; i < T * 24; i += nb * 512) {
      int tok, j; float invf;
      if (i < T * 8) { tok = i >> 3; j = i & 7; invf = 1.0f / powf(500000.0f, (float)(2 * j) / 16.0f); }
      else { const int k = i - T * 8; tok = k >> 4; j = k & 15; invf = 1.0f / powf(500000.0f, (float)(2 * j) / 32.0f); }
      const float ang = (float)pos[tok] * invf;
      double rev = (double)ang * 0.15915494309189535; rev -= rint(rev);
      const float rr = (float)(rev * 6.283185307179586);
      const float c = __cosf(rr), s = __sinf(rr);
      if (i < T * 8) { cosd[tok * 8 + j] = c; sind[tok * 8 + j] = s; } else { cosm[tok * 16 + j] = c; sinm[tok * 16 + j] = s; }
    } }
  { const f32x4* src = (const f32x4*)p.in[1]; u32x2* dst = (u32x2*)(ws + WS_PB); const size_t n = (size_t)NL * T * 256 / 4;
    const size_t stride = (size_t)nb * 512;
    size_t i = (size_t)bid * 512 + tid;
    for (; i + 3 * stride < n; i += 4 * stride) {
      f32x4 v[4];
#pragma unroll
      for (int u = 0; u < 4; ++u) v[u] = __builtin_nontemporal_load(src + i + u * stride);
#pragma unroll
      for (int u = 0; u < 4; ++u) { u32x2 w; w.x = cvt_pk_bf16(v[u][0], v[u][1]); w.y = cvt_pk_bf16(v[u][2], v[u][3]); dst[i + u * stride] = w; }
    }
    for (; i < n; i += stride) { const f32x4 v = src[i]; u32x2 w; w.x = cvt_pk_bf16(v[0], v[1]); w.y = cvt_pk_bf16(v[2], v[3]); dst[i] = w; } }
  { const int wid = tid >> 6, lane = tid & 63; float* ssq0 = (float*)(ws + WS_SSQ); bf16_t* hb = (bf16_t*)(ws + WS_HB);
    for (int row = bid * 8 + wid; row < T; row += nb * 8) {
      float sq = 0.f;
#pragma unroll
      for (int i = 0; i < 4; ++i) { const size_t off = (size_t)row * D + i * 256 + lane * 4; const f32x4 v = *(const f32x4*)(p.in[0] + off);
        store_bf4(hb + off, v); sq += v[0] * v[0] + v[1] * v[1] + v[2] * v[2] + v[3] * v[3]; }
      sq = wave_sum(sq);
      if (lane < 16) ssq0[(size_t)row * 16 + lane] = lane == 0 ? sq : 0.f;
    } }
  { constexpr int NT_KIND[10] = {1408, 704, 704, 32, 32, 256, 1408, 704, 256, 64};
    constexpr int PER_LAYER = 5568;
    const int wid = tid >> 6, lane = tid & 63;
    for (int t = bid * 8 + wid; t < NL * PER_LAYER; t += nb * 8) {
      const int layer = t / PER_LAYER; int r = t % PER_LAYER, kind = 0;
#pragma unroll
      for (int k = 0; k < 9; ++k) { if (kind == k && r >= NT_KIND[k]) { r -= NT_KIND[k]; kind = k + 1; } }
      WDesc d; get_wdesc(p, layer, kind, d);
      const int nkt = d.Kpad / 64, n0 = (r / nkt) * 64, k0 = (r % nkt) * 64;
      const int sc = wsrc_col(d.mode, n0 + lane, d.Nsrc);
      const bool live = sc >= 0 && k0 < d.K;
      const float* sp = d.src + (size_t)k0 * d.Nsrc + (sc >= 0 ? sc : 0);
      bf16_t* dp = d.dst + (size_t)(n0 + lane) * d.Kpad + k0;
      float v[64];
#pragma unroll
      for (int e = 0; e < 64; ++e) v[e] = live ? __builtin_nontemporal_load(sp + (size_t)e * d.Nsrc) : 0.f;
      if (d.gain && live) {
#pragma unroll
        for (int e = 0; e < 64; ++e) v[e] *= d.gain[k0 + e];
      }
#pragma unroll
      for (int kc = 0; kc < 8; ++kc) {
        u32x4 w; w.x = cvt_pk_bf16(v[kc * 8 + 0], v[kc * 8 + 1]); w.y = cvt_pk_bf16(v[kc * 8 + 2], v[kc * 8 + 3]); w.z = cvt_pk_bf16(v[kc * 8 + 4], v[kc * 8 + 5]); w.w = cvt_pk_bf16(v[kc * 8 + 6], v[kc * 8 + 7]);
        *(u32x4*)(dp + kc * 8) = w;
      }
    }
  }
}

__device__ __forceinline__ void rope_sweep(const Params& p) {
  unsigned char* ws = opq(p.ws); const bf16_t* ckv = (const bf16_t*)(ws + WS_CKV); bf16_t* km = (bf16_t*)(ws + WS_KM);
  const float* cosm = (const float*)(ws + WS_ROPE) + T * 16; const float* sinm = cosm + T * 16;
  for (int tok = blockIdx.x * 512 + opaque_tid(); tok < T; tok += gridDim.x * 512) {
    const bf16_t* src = ckv + (size_t)tok * 256 + 128;
    float x[32];
#pragma unroll
    for (int q = 0; q < 4; ++q) { const u32x4 w = *(const u32x4*)(src + q * 8); const unsigned* wp = (const unsigned*)&w;
#pragma unroll
      for (int j = 0; j < 4; ++j) { x[q * 8 + 2 * j] = bf2f(wp[j] & 0xffffu); x[q * 8 + 2 * j + 1] = __uint_as_float(wp[j] & 0xffff0000u); } }
    unsigned o[16];
#pragma unroll
    for (int j = 0; j < 16; j += 2) {
      const float c0 = cosm[tok * 16 + j], s0 = sinm[tok * 16 + j], c1 = cosm[tok * 16 + j + 1], s1 = sinm[tok * 16 + j + 1];
      o[j / 2] = cvt_pk_bf16(x[j] * c0 - x[j + 16] * s0, x[j + 1] * c1 - x[j + 17] * s1);
      o[8 + j / 2] = cvt_pk_bf16(x[j + 16] * c0 + x[j] * s0, x[j + 17] * c1 + x[j + 1] * s1);
    }
#pragma unroll
    for (int h = 0; h < 4; ++h) { u32x4* dst = (u32x4*)(km + (size_t)tok * 384 + h * 96 + 64);
#pragma unroll
      for (int q = 0; q < 4; ++q) { u32x4 w; w.x = o[q * 4]; w.y = o[q * 4 + 1]; w.z = o[q * 4 + 2]; w.w = o[q * 4 + 3]; dst[q] = w; } }
  }
}

__device__ __forceinline__ void final_norm(const Params& p) {
  const int tid = opaque_tid(), wid = tid >> 6, lane = tid & 63; const float* ssq = (const float*)(p.ws + WS_SSQ); const float* gain = p.in[24];
  for (int row = blockIdx.x * 8 + wid; row < T; row += gridDim.x * 8) {
    const float rs = rsqrtf(sum16(ssq + (size_t)row * 16) * (1.0f / D) + EPS);
#pragma unroll
    for (int i = 0; i < 4; ++i) { const size_t off = (size_t)row * D + i * 256 + lane * 4; f32x4 v = load_bf4((const bf16_t*)(p.ws + WS_HB2) + off); const f32x4 g = *(const f32x4*)(gain + i * 256 + lane * 4);
      v = v * rs * g;
      *(f32x4*)(p.out + off) = v; }
  }
}

constexpr int LDS_BYTES = pg8::STAGE_BYTES + 16;

__global__ void __launch_bounds__(512) mk_forward(Params p) {
  extern __shared__ __attribute__((aligned(16))) unsigned char smem[];
  LAS unsigned char* lds = (LAS unsigned char*)smem;
  cg::grid_group grid = cg::this_grid();
  if (threadIdx.x == 0) { *(LAS u32x4*)(lds + pg8::STAGE_BYTES) = (u32x4){0u, 0u, 0u, 0u}; }
  __syncthreads();
  const XcdBarrier xbar = xcd_barrier_post((unsigned*)(p.ws + WS_BAR), (volatile LAS unsigned*)(lds + pg8::STAGE_BYTES));
  unsigned char* ws = p.ws;
  const int G = gridDim.x;

  prologue(p, lds);
  grid.sync();
  { volatile LAS unsigned* st = (volatile LAS unsigned*)(lds + pg8::STAGE_BYTES);
    if (threadIdx.x == 0) {
      unsigned* bar = (unsigned*)(p.ws + WS_BAR); unsigned nx = 0, idx = 0, per = 0; bool ok = true;
      for (unsigned j = 0; j < 16; ++j) { const unsigned c = xb_ld(&bar[XB_XCNT(j)]); if (c) { if (j < xbar.x) ++idx; ++nx; if (per == 0) per = c; else if (c != per) ok = false; } }
      ok = ok && nx == 8u && per * nx == (unsigned)G && st[2] < per;
      st[3] = ok ? (0x80000000u | (st[2] * nx + idx)) : blockIdx.x;
    }
    __syncthreads(); }
  const unsigned vbw = ((volatile LAS unsigned*)(lds + pg8::STAGE_BYTES))[3];
  const int bid0 = __builtin_amdgcn_readfirstlane((int)(vbw & 0x7fffffffu));
  const bool local_ok = __builtin_amdgcn_readfirstlane((int)(vbw >> 31)) != 0;
#define SEAM_LOCAL() do { if (local_ok) xcd_barrier_local(xbar); else xcd_barrier(xbar); } while (0)

  for (int layer = 0; layer < NL; ++layer) {
    int bid = bid0; asm volatile("" : "+s"(bid));
    pg8::StaticOrder so;
    const size_t HB1 = layer ? WS_HB2 : WS_HB;
    { unsigned char* w = opq(ws); unsigned char* wl = w + WS_W + (size_t)layer * SZ_WL; float* sA = (float*)(w + WS_SSQ); float* sB = sA + (size_t)T * 16;
      so.init(T, GU, G, bid); pg8::gemm_phase<true>(lds, pg8::Gemm{(const bf16_t*)(w + HB1), (const bf16_t*)(wl + WO_GU1), T, GU, D}, so, EpiGU{sA, (bf16_t*)(w + WS_ACT)}); }
    SEAM_LOCAL();
    { unsigned char* w = opq(ws); unsigned char* wl = w + WS_W + (size_t)layer * SZ_WL; float* sA = (float*)(w + WS_SSQ); float* sB = sA + (size_t)T * 16;
      so.init(T, D, G, bid); pg8::gemm_phase<true>(lds, pg8::Gemm{(const bf16_t*)(w + WS_ACT), (const bf16_t*)(wl + WO_D1), T, D, FF}, so, EpiResP{layer ? (const float*)nullptr : opq(p.in[0]), (const bf16_t*)(w + WS_HB2), (bf16_t*)(w + WS_HB), sB, 0.5f}); }
    xcd_barrier(xbar);
    { unsigned char* w = opq(ws); unsigned char* wl = w + WS_W + (size_t)layer * SZ_WL; float* sA = (float*)(w + WS_SSQ); float* sB = sA + (size_t)T * 16;
      so.init(T, NQ, G, bid); pg8::gemm_phase(lds, pg8::Gemm{(const bf16_t*)(w + WS_HB), (const bf16_t*)(wl + WO_IN), T, NQ, D}, so,
        EpiWin{sB, (bf16_t*)(w + WS_QKV), (bf16_t*)(w + WS_CQ), (bf16_t*)(w + WS_CKV), (bf16_t*)(w + WS_VTSB), (bf16_t*)(w + WS_VTDF),
               (float*)(w + WS_SSQQ), (float*)(w + WS_SSQKV), (const float*)(w + WS_ROPE), (const float*)(w + WS_ROPE) + T * 8}); }
    xcd_barrier(xbar);
    { unsigned char* w = opq(ws); unsigned char* wl = w + WS_W + (size_t)layer * SZ_WL;
      const float* cosm = (const float*)(w + WS_ROPE) + T * 16; const float* sinm = cosm + T * 16;
      so.init(T, 512, G, bid < G / 2 ? bid : -1); pg8::gemm_phase(lds, pg8::Gemm{(const bf16_t*)(w + WS_CQ), (const bf16_t*)(wl + WO_UPQ), T, 512, 256}, so,
        EpiUpQ{(float*)(w + WS_SSQQ), (bf16_t*)(w + WS_QM), cosm, sinm});
      so.init(T, 512, G - G / 2, bid >= G / 2 ? bid - G / 2 : -1); pg8::gemm_phase(lds, pg8::Gemm{(const bf16_t*)(w + WS_CKV), (const bf16_t*)(wl + WO_UPKV), T, 512, 256}, so,
        EpiUpKV{(float*)(w + WS_SSQKV), (bf16_t*)(w + WS_KM), (bf16_t*)(w + WS_VTML)});
      rope_sweep(p); }
    { asm volatile("s_waitcnt vmcnt(0)" ::: "memory"); __syncthreads();
      if (threadIdx.x == 0) { __builtin_amdgcn_fence(__ATOMIC_RELEASE, "agent"); asm volatile("s_waitcnt vmcnt(0)" ::: "memory");
        __hip_atomic_fetch_add((unsigned*)(opq(ws) + WS_CTR) + 16 + layer, 1u, __ATOMIC_RELAXED, __HIP_MEMORY_SCOPE_AGENT); } }
    attn_phase(p, layer, lds, (int*)(opq(ws) + WS_CTR) + layer, (unsigned*)(opq(ws) + WS_CTR) + 16 + layer);
    xcd_barrier(xbar);
    { unsigned char* w = opq(ws); unsigned char* wl = w + WS_W + (size_t)layer * SZ_WL; float* sA = (float*)(w + WS_SSQ); float* sB = sA + (size_t)T * 16;
      so.init(T, D, G, bid); pg8::gemm_phase<true>(lds, pg8::Gemm{(const bf16_t*)(w + WS_MIX), (const bf16_t*)(wl + WO_OUT), T, D, D}, so, EpiResP{(const float*)nullptr, (const bf16_t*)(w + WS_HB), (bf16_t*)(w + WS_HB), sA, 1.0f}); }
    SEAM_LOCAL();
    { unsigned char* w = opq(ws); unsigned char* wl = w + WS_W + (size_t)layer * SZ_WL; float* sA = (float*)(w + WS_SSQ); float* sB = sA + (size_t)T * 16;
      so.init(T, GU, G, bid); pg8::gemm_phase<true>(lds, pg8::Gemm{(const bf16_t*)(w + WS_HB), (const bf16_t*)(wl + WO_GU2), T, GU, D}, so, EpiGU{sA, (bf16_t*)(w + WS_ACT)});
      so.init(T, D, G - G / 2, bid >= G / 2 ? bid - G / 2 : -1); pg8::gemm_phase(lds, pg8::Gemm{(const bf16_t*)(w + WS_PB) + (size_t)layer * T * 256, (const bf16_t*)(wl + WO_PJ), T, D, 256}, so, EpiProj{(bf16_t*)(w + WS_MIX)}); }
    SEAM_LOCAL();
    { unsigned char* w = opq(ws); unsigned char* wl = w + WS_W + (size_t)layer * SZ_WL; float* sA = (float*)(w + WS_SSQ); float* sB = sA + (size_t)T * 16;
      so.init(T, D, G, bid); pg8::gemm_phase<true>(lds, pg8::Gemm{(const bf16_t*)(w + WS_ACT), (const bf16_t*)(wl + WO_D2), T, D, FF}, so, EpiResP{(const float*)nullptr, (const bf16_t*)(w + WS_HB), (bf16_t*)(w + WS_HB), sB, 0.5f}); }
    SEAM_LOCAL();
    { unsigned char* w = opq(ws); unsigned char* wl = w + WS_W + (size_t)layer * SZ_WL; float* sA = (float*)(w + WS_SSQ); float* sB = sA + (size_t)T * 16;
      so.init(T, D, G, bid); pg8::gemm_phase<true>(lds, pg8::Gemm{(const bf16_t*)(w + WS_HB), (const bf16_t*)(wl + WO_GATE), T, D, D}, so, EpiPleP{sB, (const bf16_t*)(w + WS_MIX), (const bf16_t*)(w + WS_HB), (bf16_t*)(w + WS_HB2), sA}); }
    if (layer + 1 < NL) SEAM_LOCAL(); else xcd_barrier(xbar);
  }
  final_norm(p);
}

extern "C" void kernel_launch(void* const* d_in, const int* in_sizes, int n_in, void* d_out, int out_size, void* d_ws, size_t ws_size, hipStream_t stream) {
  static int grid = 0;
  if (grid == 0) {
    int dev = 0, cus = 0, per_cu = 0;
    if (n_in != 25 || out_size != T * D || ws_size < WS_END) { fprintf(stderr, "kernel_launch: unexpected shapes (n_in %d out %d ws %zu need %zu)\n", n_in, out_size, ws_size, (size_t)WS_END); grid = -1; return; }
    (void)hipGetDevice(&dev);
    (void)hipDeviceGetAttribute(&cus, hipDeviceAttributeMultiprocessorCount, dev);
    if (hipFuncSetAttribute((const void*)mk_forward, hipFuncAttributeMaxDynamicSharedMemorySize, LDS_BYTES) != hipSuccess) { fprintf(stderr, "kernel_launch: hipFuncSetAttribute failed\n"); grid = -1; return; }
    (void)hipOccupancyMaxActiveBlocksPerMultiprocessor(&per_cu, (const void*)mk_forward, 512, LDS_BYTES);
    (void)hipGetLastError();
    if (per_cu < 1) fprintf(stderr, "kernel_launch: occupancy query says %d blocks per CU\n", per_cu);
    grid = cus;
  }
  if (grid < 0) return;
  Params p{};
  for (int i = 0; i < 25; ++i) p.in[i] = (const float*)d_in[i];
  p.out = (float*)d_out; p.ws = (unsigned char*)d_ws;
  if (hipMemsetAsync((unsigned char*)d_ws + WS_BAR, 0, XCD_BAR_WORDS * 4, stream) != hipSuccess) { fprintf(stderr, "kernel_launch: memset of the barrier words failed\n"); return; }
  void* args[] = {&p};
  hipError_t e = hipLaunchCooperativeKernel((const void*)mk_forward, dim3(grid), dim3(512), args, LDS_BYTES, stream);
  if (e != hipSuccess) fprintf(stderr, "kernel_launch: cooperative launch failed: %s (grid %d)\n", hipGetErrorString(e), grid);
}
```

```cpp
#include <hip/hip_runtime.h>
#include <hip/hip_cooperative_groups.h>
#include <cstdio>
namespace cg = cooperative_groups;

#define LAS __attribute__((address_space(3)))
typedef unsigned short bf16_t;
typedef short bf16x8 __attribute__((ext_vector_type(8)));
typedef float f32x4 __attribute__((ext_vector_type(4)));
typedef float f32x16 __attribute__((ext_vector_type(16)));
typedef unsigned u32x4 __attribute__((ext_vector_type(4)));
typedef unsigned u32x2 __attribute__((ext_vector_type(2)));

constexpr int T = 16384, SEQ = 4096, D = 1024, FF = 2816, GU = 5632, NQ = 2816, QW = 2304, NL = 4;
constexpr float EPS = 1e-6f;
constexpr float LOG2E = 1.4426950408889634f, LN2 = 0.6931471805599453f;

constexpr size_t al(size_t x) { return (x + 255) & ~(size_t)255; }
constexpr size_t SZ_WGU = (size_t)GU * D * 2, SZ_WD = (size_t)D * FF * 2, SZ_WIN = (size_t)NQ * D * 2, SZ_WUP = (size_t)512 * 256 * 2,
                 SZ_WSQ = (size_t)D * D * 2, SZ_WPJ = (size_t)D * 256 * 2;
constexpr size_t WO_GU1 = 0, WO_D1 = WO_GU1 + SZ_WGU, WO_IN = WO_D1 + SZ_WD, WO_UPQ = WO_IN + SZ_WIN, WO_UPKV = WO_UPQ + SZ_WUP,
                 WO_OUT = WO_UPKV + SZ_WUP, WO_GU2 = WO_OUT + SZ_WSQ, WO_D2 = WO_GU2 + SZ_WGU, WO_GATE = WO_D2 + SZ_WD, WO_PJ = WO_GATE + SZ_WSQ,
                 SZ_WL = WO_PJ + SZ_WPJ;
constexpr size_t WS_W = 0;
constexpr size_t WS_HB = al(WS_W + NL * SZ_WL);
constexpr size_t WS_ACT = al(WS_HB + (size_t)T * D * 2);
constexpr size_t WS_QKV = WS_ACT;
constexpr size_t WS_CQ = al(WS_QKV + (size_t)T * QW * 2);
constexpr size_t WS_CKV = al(WS_CQ + (size_t)T * 256 * 2);
constexpr size_t WS_ACT_END = al(WS_CKV + (size_t)T * 256 * 2) > al(WS_ACT + (size_t)T * FF * 2) ? al(WS_CKV + (size_t)T * 256 * 2) : al(WS_ACT + (size_t)T * FF * 2);
constexpr size_t WS_MIX = WS_ACT_END;
constexpr size_t WS_PB = al(WS_MIX + (size_t)T * D * 2);
constexpr size_t WS_VTSB = al(WS_PB + (size_t)NL * T * 256 * 2);
constexpr size_t WS_VTDF = al(WS_VTSB + (size_t)16 * 64 * SEQ * 2);
constexpr size_t WS_VTML = al(WS_VTDF + (size_t)16 * 128 * SEQ * 2);
constexpr size_t WS_QM = al(WS_VTML + (size_t)16 * 64 * SEQ * 2);
constexpr size_t WS_KM = al(WS_QM + (size_t)T * 384 * 2);
constexpr size_t WS_SSQ = al(WS_KM + (size_t)T * 384 * 2);
constexpr size_t WS_SSQQ = WS_SSQ + (size_t)2 * T * 16 * 4;
constexpr size_t WS_SSQKV = WS_SSQQ + (size_t)T * 4 * 4;
constexpr size_t WS_CTR = WS_SSQKV + (size_t)T * 4 * 4;
constexpr size_t WS_BAR = al(WS_CTR + 256);
constexpr size_t WS_ROPE = al(WS_BAR + 5504 * 4);
constexpr size_t WS_STASH = al(WS_ROPE + (size_t)T * 48 * 4);
constexpr size_t WS_END = al(WS_STASH + (size_t)256 * 16 * 512 * 16);
constexpr size_t WS_HB2 = WS_VTML;
static_assert(WS_HB2 + (size_t)T * D * 2 <= WS_SSQ, "hb2 alias overflows");

struct Params { const float* in[25]; float* out; unsigned char* ws; };

typedef __bf16 bf16x2_t __attribute__((ext_vector_type(2)));
typedef float f32x2_t __attribute__((ext_vector_type(2)));
__device__ __forceinline__ unsigned cvt_pk_bf16(float lo, float hi) { f32x2_t v = {lo, hi}; bf16x2_t b = __builtin_convertvector(v, bf16x2_t); return __builtin_bit_cast(unsigned, b); }
__device__ __forceinline__ bf16_t f2bf(float f) { unsigned u = __float_as_uint(f); u += 0x7FFFu + ((u >> 16) & 1u); return (bf16_t)(u >> 16); }
__device__ __forceinline__ float bf2f(unsigned v) { return __uint_as_float(v << 16); }
__device__ __forceinline__ float fexp2(float x) { return __builtin_amdgcn_exp2f(x); }
__device__ __forceinline__ float flog2(float x) { return __builtin_amdgcn_logf(x); }
__device__ __forceinline__ float frcp(float x) { return __builtin_amdgcn_rcpf(x); }
__device__ __forceinline__ int opaque_tid() { int t = threadIdx.x; asm volatile("" : "+v"(t)); return t; }
template <class P> __device__ __forceinline__ P* opq(P* p) { unsigned z; asm volatile("s_mov_b32 %0, 0" : "=s"(z)); return (P*)((unsigned char*)p + z); }
__device__ __forceinline__ float sum16(const float* p) { const f32x4 a = *(const f32x4*)p, b = *(const f32x4*)(p + 4), c = *(const f32x4*)(p + 8), d = *(const f32x4*)(p + 12);
  return (((a[0] + a[1]) + (a[2] + a[3])) + ((b[0] + b[1]) + (b[2] + b[3]))) + (((c[0] + c[1]) + (c[2] + c[3])) + ((d[0] + d[1]) + (d[2] + d[3]))); }
__device__ __forceinline__ float sum4(const float* p) { const f32x4 a = *(const f32x4*)p; return (a[0] + a[1]) + (a[2] + a[3]); }
__device__ __forceinline__ float row_rstd(const float* part, int row, int fq) {
  float s = sum4(part + (size_t)row * 16 + fq * 4); s += __shfl_xor(s, 16); s += __shfl_xor(s, 32); return rsqrtf(s * (1.0f / D) + EPS); }
__device__ __forceinline__ float wave_sum(float v) {
  v += __shfl_xor(v, 32); v += __shfl_xor(v, 16); v += __shfl_xor(v, 8); v += __shfl_xor(v, 4); v += __shfl_xor(v, 2); v += __shfl_xor(v, 1); return v;
}


#define XB_TMO      128
#define XB_XCNT(j)  (256  + 64 * (j))
#define XB_XSUB(j)  (1280 + 64 * (j))
#define XB_XGEN(j)  (2304 + 64 * (j))
#define XB_TOP      3328
#define XB_TOPGEN   3392
#define XB_LSUB(j)  (3456 + 64 * (j))
#define XB_LGEN(j)  (4480 + 64 * (j))
#define XCD_BAR_WORDS 5504
#define XB_SPIN_CAP (1u << 18)
__device__ __forceinline__ unsigned xb_ld(unsigned* p)              { return __hip_atomic_load(p, __ATOMIC_RELAXED, __HIP_MEMORY_SCOPE_AGENT); }
__device__ __forceinline__ unsigned xb_add(unsigned* p, unsigned v) { return __hip_atomic_fetch_add(p, v, __ATOMIC_RELAXED, __HIP_MEMORY_SCOPE_AGENT); }
__device__ __forceinline__ unsigned xb_xcc_id() { return (unsigned)__builtin_amdgcn_s_getreg((3 << 11) | 20) & 0xFu; }
#define XB_SPIN(cond, bar) do { unsigned _sp = 0; while (cond) { __builtin_amdgcn_s_sleep(1); \
    if ((++_sp & 255u) == 0u) { if (xb_ld(&(bar)[XB_TMO])) break; if (_sp > XB_SPIN_CAP) { atomicAdd(&(bar)[XB_TMO], 1u); break; } } } } while (0)
struct XcdBarrier { unsigned* bar; unsigned x; volatile LAS unsigned* st; };
__device__ __forceinline__ XcdBarrier xcd_barrier_post(unsigned* bar, volatile LAS unsigned* st) {
  XcdBarrier b; b.bar = bar; b.x = xb_xcc_id(); b.st = st;
  if (threadIdx.x == 0) st[2] = xb_add(&bar[XB_XCNT(b.x)], 1u);
  return b;
}
__device__ __forceinline__ void xcd_barrier_complete(unsigned* bar, unsigned x, unsigned& nloc, unsigned& nx) {
  const unsigned G = gridDim.x * gridDim.y * gridDim.z;
  unsigned sum, cnt, mine, sp = 0u;
  for (;;) {
    sum = 0u; cnt = 0u; mine = 0u;
#pragma unroll
    for (unsigned j = 0; j < 16; ++j) { const unsigned c = xb_ld(&bar[XB_XCNT(j)]); sum += c; cnt += (c > 0u) ? 1u : 0u; mine = (j == x) ? c : mine; }
    if (sum == G) break;
    __builtin_amdgcn_s_sleep(1);
    if ((++sp & 255u) == 0u) { if (xb_ld(&bar[XB_TMO])) break; if (sp > XB_SPIN_CAP) { atomicAdd(&bar[XB_TMO], 1u); break; } }
  }
  nloc = mine > 0u ? mine : 1u; nx = cnt > 0u ? cnt : 1u;
}
__device__ __forceinline__ void xcd_barrier(const XcdBarrier& b) {
  asm volatile("s_waitcnt vmcnt(0)" ::: "memory");
  __syncthreads();
  if (threadIdx.x == 0) {
    unsigned* bar = b.bar;
    __builtin_amdgcn_s_waitcnt(0);
    unsigned nloc = b.st[0], nx = b.st[1];
    if (nloc == 0u) { xcd_barrier_complete(bar, b.x, nloc, nx); b.st[0] = nloc; b.st[1] = nx; }
    const unsigned old = xb_add(&bar[XB_XSUB(b.x)], 1u);
    const unsigned gen = old / nloc;
    if (old + 1u == (gen + 1u) * nloc) {
      __builtin_amdgcn_fence(__ATOMIC_RELEASE, "agent");
      asm volatile("s_waitcnt vmcnt(0)" ::: "memory");
      const unsigned og = xb_add(&bar[XB_TOP], 1u);
      const unsigned tg = og / nx;
      if (og + 1u == (tg + 1u) * nx) xb_add(&bar[XB_TOPGEN], 1u);
      else XB_SPIN(xb_ld(&bar[XB_TOPGEN]) == tg, bar);
      __builtin_amdgcn_fence(__ATOMIC_ACQUIRE, "agent");
      xb_add(&bar[XB_XGEN(b.x)], 1u);
      asm volatile("s_waitcnt vmcnt(0)" ::: "memory");
    } else {
      XB_SPIN(xb_ld(&bar[XB_XGEN(b.x)]) == gen, bar);
      __builtin_amdgcn_fence(__ATOMIC_ACQUIRE, "agent");
      asm volatile("s_waitcnt vmcnt(0)" ::: "memory");
    }
  }
  __syncthreads();
}

__device__ __forceinline__ void xcd_barrier_local(const XcdBarrier& b) {
  asm volatile("s_waitcnt vmcnt(0)" ::: "memory");
  __syncthreads();
  if (threadIdx.x == 0) {
    unsigned* bar = b.bar;
    __builtin_amdgcn_s_waitcnt(0);
    unsigned nloc = b.st[0], nx = b.st[1];
    if (nloc == 0u) { xcd_barrier_complete(bar, b.x, nloc, nx); b.st[0] = nloc; b.st[1] = nx; }
    const unsigned old = xb_add(&bar[XB_LSUB(b.x)], 1u);
    const unsigned gen = old / nloc;
    if (old + 1u == (gen + 1u) * nloc) xb_add(&bar[XB_LGEN(b.x)], 1u);
    else XB_SPIN(xb_ld(&bar[XB_LGEN(b.x)]) == gen, bar);
    __builtin_amdgcn_fence(__ATOMIC_ACQUIRE, "agent");
    asm volatile("s_waitcnt vmcnt(0)" ::: "memory");
  }
  __syncthreads();
}

namespace pg8 {
constexpr int BM = 256, BK = 64, HALF = 128, HTB = HALF * BK * 2, STAGE_BYTES = 8 * HTB, NXCD = 8, WGM = 8;
__host__ __device__ __forceinline__ int lds_byte(int r, int c) { const int st = (r >> 4) * 2 + (c >> 5), rr = r & 15, cc = c & 31, ob = rr * 64 + cc * 2; return st * 1024 + (ob ^ (((ob >> 9) & 1) << 5)); }
__host__ __device__ __forceinline__ void stage_rc(int b, int& R, int& C) { const int st = b / 1024, sb = b % 1024, swz = sb ^ (((sb >> 9) & 1) << 5); R = (st >> 1) * 16 + swz / 64; C = (st & 1) * 32 + (swz % 64) / 2; }
struct Unit { int pm, pn; };
struct Gemm { const bf16_t* A; const bf16_t* Bt; int M, N, K; };
__device__ __forceinline__ void map_tile(int L, int nM, int nN, Unit& u) {
  const int nwg = nM * nN; int wgid = L;
  { const int q = nwg / NXCD, r = nwg % NXCD, xcd = wgid % NXCD, off = wgid / NXCD; wgid = (xcd < r ? xcd * (q + 1) : r * (q + 1) + (xcd - r) * q) + off; }
  const int nig = WGM * nN, gid = wgid / nig, fm = gid * WGM, gsz = (nM - fm) < WGM ? (nM - fm) : WGM;
  u.pm = fm + ((wgid % nig) % gsz); u.pn = (wgid % nig) / gsz;
}
struct StaticOrder {
  int nM, nN, nwg, G, c;
  __device__ void init(int M, int N, int G_, int c_) { nM = M / BM; nN = N / BM; nwg = nM * nN; G = G_; c = c_; }
  __device__ bool next(int i, Unit& u) const { const long L = (long)i * G + c; if (L >= nwg || c < 0) return false; map_tile((int)L, nM, nN, u); return true; }
};

__host__ __device__ __forceinline__ int perm32(int rho) { const int n = rho >> 4, i = rho & 15; return 8 * (i >> 2) + 4 * n + (i & 3); }
template <bool PERM = false, class Epi, class Sched>
__device__ __forceinline__ void gemm_phase(LAS unsigned char* lds, const Gemm g, const Sched& S, const Epi& E) {
  const int tid = opaque_tid(), wid = __builtin_amdgcn_readfirstlane(tid >> 6), lane = tid & 63, wr = wid >> 2, wc = wid & 3, fr = lane & 15, fq = lane >> 4;
  const int K = g.K, nt = K / BK;
  unsigned voffA[2], voffB[2];
#pragma unroll
  for (int i = 0; i < 2; ++i) { int R, C; stage_rc(tid * 16 + i * 8192, R, C); const int Rb = PERM ? ((R & ~31) + perm32(R & 31)) : R;
    voffA[i] = (unsigned)(R * K + C) * 2u; voffB[i] = (unsigned)(Rb * K + C) * 2u; }
  const size_t kstep = (size_t)(BK * 2);
  const size_t hstep = (size_t)HALF * K * 2;
  const size_t tstep = 2 * hstep;
  const unsigned ldsw = (unsigned)wid * 1024u;
  const int aoff = lds_byte(wr * 64 + fr, fq * 8), boff = lds_byte(wc * 32 + fr, fq * 8);
#define PG8_SA(b, h) (((b) * 2 + (h)) * HTB)
#define PG8_SB(b, h) ((4 + (b) * 2 + (h)) * HTB)
#define PG8_STAGE(bufoff, gbase, voff) do { _Pragma("unroll") for (int _i = 0; _i < 2; ++_i) \
    __builtin_amdgcn_global_load_lds((const unsigned*)((const char*)(gbase) + (voff)[_i]), (LAS unsigned*)(lds + (bufoff) + ldsw + _i * 8192), 16, 0, 0); } while (0)
#define PG8_LDA(dst, b, h) do { _Pragma("unroll") for (int m = 0; m < 4; ++m) _Pragma("unroll") for (int k = 0; k < 2; ++k) dst[m][k] = *(const LAS bf16x8*)(lds + PG8_SA(b, h) + aoff + m * 2048 + k * 1024); } while (0)
#define PG8_LDB(dst, b, h) do { _Pragma("unroll") for (int n = 0; n < 2; ++n) _Pragma("unroll") for (int k = 0; k < 2; ++k) dst[n][k] = *(const LAS bf16x8*)(lds + PG8_SB(b, h) + boff + n * 2048 + k * 1024); } while (0)
#define PG8_MMA(ai, bj, At, Bt) do { __builtin_amdgcn_s_setprio(1); _Pragma("unroll") for (int m = 0; m < 4; ++m) _Pragma("unroll") for (int n = 0; n < 2; ++n) _Pragma("unroll") for (int k = 0; k < 2; ++k) \
    acc[ai][bj][m][n] = __builtin_amdgcn_mfma_f32_16x16x32_bf16(Bt[n][k], At[m][k], acc[ai][bj][m][n], 0, 0, 0); __builtin_amdgcn_s_setprio(0); } while (0)
#define PG8_WAIT_V(n) asm volatile("s_waitcnt vmcnt(" #n ")" ::: "memory")
#define PG8_WAIT_L(n) asm volatile("s_waitcnt lgkmcnt(" #n ")" ::: "memory")
#define PG8_BAR __builtin_amdgcn_s_barrier()
#define PG8_SCHED __builtin_amdgcn_sched_barrier(0)
  Unit cur, nxt; int ui = 0;
  if (!S.next(0, cur)) return;
  f32x4 acc[2][2][4][2];
#pragma unroll
  for (int a = 0; a < 2; ++a)
#pragma unroll
    for (int b = 0; b < 2; ++b)
#pragma unroll
      for (int m = 0; m < 4; ++m)
#pragma unroll
        for (int n = 0; n < 2; ++n) acc[a][b][m][n] = (f32x4){0.f, 0.f, 0.f, 0.f};
  bf16x8 At[4][2], B0[2][2], B1[2][2];
  const char* cA = (const char*)g.A + (size_t)cur.pm * tstep; const char* cB = (const char*)g.Bt + (size_t)cur.pn * tstep;
  PG8_STAGE(PG8_SB(0, 0), cB, voffB); PG8_STAGE(PG8_SA(0, 0), cA, voffA); PG8_STAGE(PG8_SB(0, 1), cB + hstep, voffB); PG8_STAGE(PG8_SA(0, 1), cA + hstep, voffA);
  if (wr == 1) PG8_BAR;
  PG8_WAIT_V(4); PG8_BAR;
  PG8_STAGE(PG8_SB(1, 0), cB + kstep, voffB); PG8_STAGE(PG8_SA(1, 0), cA + kstep, voffA); PG8_STAGE(PG8_SB(1, 1), cB + hstep + kstep, voffB);
  PG8_WAIT_V(6); PG8_BAR;
  for (;;) {
    const bool has_next = S.next(ui + 1, nxt);
    const char* nA = has_next ? (const char*)g.A + (size_t)nxt.pm * tstep : cA; const char* nB = has_next ? (const char*)g.Bt + (size_t)nxt.pn * tstep : cB;
#pragma unroll 1
    for (int t = 0; t < nt; t += 2) {
      const bool last = (t == nt - 2);
      const char* a1 = cA + (size_t)(t + 1) * kstep;
      const char* a2 = last ? nA : cA + (size_t)(t + 2) * kstep; const char* b2 = last ? nB : cB + (size_t)(t + 2) * kstep;
      const char* a3 = a2 + kstep; const char* b3 = b2 + kstep;
      PG8_LDB(B0, 0, 0); PG8_SCHED; PG8_LDA(At, 0, 0); PG8_STAGE(PG8_SA(1, 1), a1 + hstep, voffA);
      PG8_WAIT_L(8); PG8_BAR; PG8_WAIT_L(0); PG8_MMA(0, 0, At, B0); PG8_BAR; PG8_SCHED;
      PG8_LDB(B1, 0, 1); PG8_STAGE(PG8_SB(0, 0), b2, voffB);
      PG8_BAR; PG8_WAIT_L(0); PG8_MMA(0, 1, At, B1); PG8_BAR;
      PG8_LDA(At, 0, 1); PG8_STAGE(PG8_SA(0, 0), a2, voffA);
      PG8_BAR; PG8_WAIT_L(0); PG8_MMA(1, 0, At, B0); PG8_BAR; PG8_SCHED;
      PG8_STAGE(PG8_SB(0, 1), b2 + hstep, voffB);
      PG8_WAIT_V(6); PG8_BAR; PG8_MMA(1, 1, At, B1); PG8_BAR;
      PG8_LDB(B0, 1, 0); PG8_SCHED; PG8_LDA(At, 1, 0); PG8_STAGE(PG8_SA(0, 1), a2 + hstep, voffA);
      PG8_WAIT_L(8); PG8_BAR; PG8_WAIT_L(0); PG8_MMA(0, 0, At, B0); PG8_BAR; PG8_SCHED;
      PG8_LDB(B1, 1, 1); PG8_STAGE(PG8_SB(1, 0), b3, voffB);
      PG8_BAR; PG8_WAIT_L(0); PG8_MMA(0, 1, At, B1); PG8_BAR;
      PG8_LDA(At, 1, 1); PG8_STAGE(PG8_SA(1, 0), a3, voffA);
      PG8_BAR; PG8_WAIT_L(0); PG8_MMA(1, 0, At, B0); PG8_BAR; PG8_SCHED;
      PG8_STAGE(PG8_SB(1, 1), b3 + hstep, voffB);
      PG8_WAIT_V(6); PG8_BAR; PG8_MMA(1, 1, At, B1); PG8_BAR;
    }
    E(acc, cur, wr, wc, fr, fq);
    if (!has_next) break;
#pragma unroll
    for (int a = 0; a < 2; ++a)
#pragma unroll
      for (int b = 0; b < 2; ++b)
#pragma unroll
        for (int m = 0; m < 4; ++m)
#pragma unroll
          for (int n = 0; n < 2; ++n) acc[a][b][m][n] = (f32x4){0.f, 0.f, 0.f, 0.f};
    cur = nxt; cA = nA; cB = nB; ++ui;
  }
  PG8_WAIT_V(0);
  if (wr == 0) PG8_BAR;
  PG8_BAR;
#undef PG8_SA
#undef PG8_SB
#undef PG8_STAGE
#undef PG8_LDA
#undef PG8_LDB
#undef PG8_MMA
#undef PG8_WAIT_V
#undef PG8_WAIT_L
#undef PG8_BAR
#undef PG8_SCHED
}
}
using pg8::Unit;

#define EPI_ROWS(...) _Pragma("unroll") for (int ai = 0; ai < 2; ++ai) _Pragma("unroll") for (int m = 0; m < 4; ++m) { const int row = u.pm * 256 + ai * 128 + wr * 64 + m * 16 + fr; __VA_ARGS__ }

__device__ __forceinline__ f32x4 load_bf4(const bf16_t* p) { const u32x2 w = *(const u32x2*)p; f32x4 v; v[0] = __uint_as_float(w.x << 16); v[1] = __uint_as_float(w.x & 0xffff0000u); v[2] = __uint_as_float(w.y << 16); v[3] = __uint_as_float(w.y & 0xffff0000u); return v; }
__device__ __forceinline__ void store_bf4(bf16_t* p, f32x4 v) { u32x2 w; w.x = cvt_pk_bf16(v[0], v[1]); w.y = cvt_pk_bf16(v[2], v[3]); *(u32x2*)p = w; }
__device__ __forceinline__ int vt_pos(int w) { return 8 * ((w >> 2) & 1) + 4 * (w >> 3) + (w & 3); }

__device__ __forceinline__ void load_bf8(const bf16_t* p, f32x4& a, f32x4& b) { const u32x4 w = *(const u32x4*)p;
  a[0] = __uint_as_float(w.x << 16); a[1] = __uint_as_float(w.x & 0xffff0000u); a[2] = __uint_as_float(w.y << 16); a[3] = __uint_as_float(w.y & 0xffff0000u);
  b[0] = __uint_as_float(w.z << 16); b[1] = __uint_as_float(w.z & 0xffff0000u); b[2] = __uint_as_float(w.w << 16); b[3] = __uint_as_float(w.w & 0xffff0000u); }
__device__ __forceinline__ void store_bf8(bf16_t* p, const f32x4& a, const f32x4& b) { u32x4 w; w.x = cvt_pk_bf16(a[0], a[1]); w.y = cvt_pk_bf16(a[2], a[3]); w.z = cvt_pk_bf16(b[0], b[1]); w.w = cvt_pk_bf16(b[2], b[3]); *(u32x4*)p = w; }
struct EpiGU {
  const float* ssq; bf16_t* act;
  __device__ __forceinline__ void operator()(const f32x4 (&acc)[2][2][4][2], const Unit& u, int wr, int wc, int fr, int fq) const {
    float rsv[2][4];
    _Pragma("unroll") for (int ai = 0; ai < 2; ++ai) _Pragma("unroll") for (int m = 0; m < 4; ++m) rsv[ai][m] = row_rstd(ssq, u.pm * 256 + ai * 128 + wr * 64 + m * 16 + fr, fq);
    EPI_ROWS(
      const float rs = rsv[ai][m];
      f32x4 o[2];
      _Pragma("unroll") for (int n = 0; n < 2; ++n) {
        const f32x4 g = acc[ai][0][m][n] * rs, v = acc[ai][1][m][n] * rs;
        _Pragma("unroll") for (int j = 0; j < 4; ++j) o[n][j] = g[j] * frcp(1.0f + fexp2(-g[j] * LOG2E)) * v[j]; }
      store_bf8(act + (size_t)row * FF + u.pn * 128 + wc * 32 + fq * 8, o[0], o[1]);
    )
  }
};
struct EpiRes {
  const float* rin_f; const bf16_t* rin_b; bf16_t* hb; float* ssq_out; float scale;
  __device__ __forceinline__ void operator()(const f32x4 (&acc)[2][2][4][2], const Unit& u, int wr, int wc, int fr, int fq) const {
    EPI_ROWS(
      const size_t off = (size_t)row * D + u.pn * 256 + wc * 32 + fq * 4; float sq = 0.f;
      _Pragma("unroll") for (int bj = 0; bj < 2; ++bj) _Pragma("unroll") for (int n = 0; n < 2; ++n) {
        const size_t o2 = off + bj * 128 + n * 16;
        f32x4 hv = rin_f ? *(const f32x4*)(rin_f + o2) : load_bf4(rin_b + o2); hv += acc[ai][bj][m][n] * scale;
        store_bf4(hb + o2, hv);
        sq += hv[0] * hv[0] + hv[1] * hv[1] + hv[2] * hv[2] + hv[3] * hv[3]; }
      sq += __shfl_xor(sq, 16); sq += __shfl_xor(sq, 32);
      if (fq == 0) ssq_out[(size_t)row * 16 + u.pn * 4 + wc] = sq;
    )
  }
};
struct EpiPle {
  const float* ssq_in; const bf16_t* proj; const bf16_t* rin; bf16_t* hb; float* ssq_out;
  __device__ __forceinline__ void operator()(const f32x4 (&acc)[2][2][4][2], const Unit& u, int wr, int wc, int fr, int fq) const {
    EPI_ROWS(
      const float rs = rsqrtf(sum16(ssq_in + (size_t)row * 16) * (1.0f / D) + EPS);
      const size_t off = (size_t)row * D + u.pn * 256 + wc * 32 + fq * 4; float sq = 0.f;
      _Pragma("unroll") for (int bj = 0; bj < 2; ++bj) _Pragma("unroll") for (int n = 0; n < 2; ++n) {
        const size_t o2 = off + bj * 128 + n * 16;
        f32x4 hv = load_bf4(rin + o2); const f32x4 pr = load_bf4(proj + o2);
        _Pragma("unroll") for (int j = 0; j < 4; ++j) { const float gt = frcp(1.0f + fexp2(-acc[ai][bj][m][n][j] * rs * LOG2E)); hv[j] += pr[j] * gt; }
        store_bf4(hb + o2, hv);
        sq += hv[0] * hv[0] + hv[1] * hv[1] + hv[2] * hv[2] + hv[3] * hv[3]; }
      sq += __shfl_xor(sq, 16); sq += __shfl_xor(sq, 32);
      if (fq == 0) ssq_out[(size_t)row * 16 + u.pn * 4 + wc] = sq;
    )
  }
};
__device__ __forceinline__ void unpack_bf8(const u32x4& w, f32x4& a, f32x4& b) {
  a[0] = __uint_as_float(w.x << 16); a[1] = __uint_as_float(w.x & 0xffff0000u); a[2] = __uint_as_float(w.y << 16); a[3] = __uint_as_float(w.y & 0xffff0000u);
  b[0] = __uint_as_float(w.z << 16); b[1] = __uint_as_float(w.z & 0xffff0000u); b[2] = __uint_as_float(w.w << 16); b[3] = __uint_as_float(w.w & 0xffff0000u); }
struct EpiResP {
  const float* rin_f; const bf16_t* rin_b; bf16_t* hb; float* ssq_out; float scale;
  __device__ __forceinline__ void operator()(const f32x4 (&acc)[2][2][4][2], const Unit& u, int wr, int wc, int fr, int fq) const {
    _Pragma("unroll") for (int ai = 0; ai < 2; ++ai) {
      const size_t off0 = (size_t)(u.pm * 256 + ai * 128 + wr * 64 + fr) * D + u.pn * 256 + wc * 32 + fq * 8;
      f32x4 h0[4][2]; f32x4 h1[4][2];
      if (rin_f) {
        _Pragma("unroll") for (int m = 0; m < 4; ++m) _Pragma("unroll") for (int bj = 0; bj < 2; ++bj) {
          const size_t o2 = off0 + (size_t)m * 16 * D + bj * 128; h0[m][bj] = *(const f32x4*)(rin_f + o2); h1[m][bj] = *(const f32x4*)(rin_f + o2 + 4); }
      } else {
        u32x4 w[4][2];
        _Pragma("unroll") for (int m = 0; m < 4; ++m) _Pragma("unroll") for (int bj = 0; bj < 2; ++bj) w[m][bj] = *(const u32x4*)(rin_b + off0 + (size_t)m * 16 * D + bj * 128);
        _Pragma("unroll") for (int m = 0; m < 4; ++m) _Pragma("unroll") for (int bj = 0; bj < 2; ++bj) unpack_bf8(w[m][bj], h0[m][bj], h1[m][bj]);
      }
      _Pragma("unroll") for (int m = 0; m < 4; ++m) {
        const int row = u.pm * 256 + ai * 128 + wr * 64 + m * 16 + fr; float sq = 0.f;
        _Pragma("unroll") for (int bj = 0; bj < 2; ++bj) {
          f32x4 a = h0[m][bj] + acc[ai][bj][m][0] * scale, b = h1[m][bj] + acc[ai][bj][m][1] * scale;
          store_bf8(hb + off0 + (size_t)m * 16 * D + bj * 128, a, b);
          sq += (a[0] * a[0] + a[1] * a[1] + a[2] * a[2] + a[3] * a[3]) + (b[0] * b[0] + b[1] * b[1] + b[2] * b[2] + b[3] * b[3]); }
        sq += __shfl_xor(sq, 16); sq += __shfl_xor(sq, 32);
        if (fq == 0) ssq_out[(size_t)row * 16 + u.pn * 4 + wc] = sq;
      }
    }
  }
};
struct EpiPleP {
  const float* ssq_in; const bf16_t* proj; const bf16_t* rin; bf16_t* hb; float* ssq_out;
  __device__ __forceinline__ void operator()(const f32x4 (&acc)[2][2][4][2], const Unit& u, int wr, int wc, int fr, int fq) const {
    _Pragma("unroll") for (int ai = 0; ai < 2; ++ai) {
      const size_t off0 = (size_t)(u.pm * 256 + ai * 128 + wr * 64 + fr) * D + u.pn * 256 + wc * 32 + fq * 8;
      float rsv[4];
      _Pragma("unroll") for (int m = 0; m < 4; ++m) rsv[m] = row_rstd(ssq_in, u.pm * 256 + ai * 128 + wr * 64 + m * 16 + fr, fq);
      u32x4 wr_[4][2]; u32x4 wp[4][2];
      _Pragma("unroll") for (int m = 0; m < 4; ++m) _Pragma("unroll") for (int bj = 0; bj < 2; ++bj) {
        const size_t o2 = off0 + (size_t)m * 16 * D + bj * 128; wr_[m][bj] = *(const u32x4*)(rin + o2); wp[m][bj] = *(const u32x4*)(proj + o2); }
      _Pragma("unroll") for (int m = 0; m < 4; ++m) {
        const int row = u.pm * 256 + ai * 128 + wr * 64 + m * 16 + fr; float sq = 0.f;
        const float rs = rsv[m];
        _Pragma("unroll") for (int bj = 0; bj < 2; ++bj) {
          f32x4 h0; f32x4 h1; f32x4 p0; f32x4 p1; unpack_bf8(wr_[m][bj], h0, h1); unpack_bf8(wp[m][bj], p0, p1);
          _Pragma("unroll") for (int j = 0; j < 4; ++j) {
            h0[j] += p0[j] * frcp(1.0f + fexp2(-acc[ai][bj][m][0][j] * rs * LOG2E));
            h1[j] += p1[j] * frcp(1.0f + fexp2(-acc[ai][bj][m][1][j] * rs * LOG2E)); }
          store_bf8(hb + off0 + (size_t)m * 16 * D + bj * 128, h0, h1);
          sq += (h0[0] * h0[0] + h0[1] * h0[1] + h0[2] * h0[2] + h0[3] * h0[3]) + (h1[0] * h1[0] + h1[1] * h1[1] + h1[2] * h1[2] + h1[3] * h1[3]); }
        sq += __shfl_xor(sq, 16); sq += __shfl_xor(sq, 32);
        if (fq == 0) ssq_out[(size_t)row * 16 + u.pn * 4 + wc] = sq;
      }
    }
  }
};
struct EpiProj {
  bf16_t* proj;
  __device__ __forceinline__ void operator()(const f32x4 (&acc)[2][2][4][2], const Unit& u, int wr, int wc, int fr, int fq) const {
    EPI_ROWS(
      const size_t off = (size_t)row * D + u.pn * 256 + wc * 32 + fq * 4;
      _Pragma("unroll") for (int bj = 0; bj < 2; ++bj) _Pragma("unroll") for (int n = 0; n < 2; ++n) store_bf4(proj + off + bj * 128 + n * 16, acc[ai][bj][m][n]);
    )
  }
};
struct EpiWin {
  const float* ssq_in; bf16_t* qkv; bf16_t* cq; bf16_t* ckv; bf16_t* vtsb; bf16_t* vtdf; float* ssqq; float* ssqkv; const float* cosd; const float* sind;
  __device__ __forceinline__ void operator()(const f32x4 (&acc)[2][2][4][2], const Unit& u, int wr, int wc, int fr, int fq) const {
    const int pn = u.pn;
    float rsv[2][4];
    _Pragma("unroll") for (int ai = 0; ai < 2; ++ai) _Pragma("unroll") for (int m = 0; m < 4; ++m) rsv[ai][m] = row_rstd(ssq_in, u.pm * 256 + ai * 128 + wr * 64 + m * 16 + fr, fq);
    EPI_ROWS(
      const float rs = rsv[ai][m];
      if (pn == 2 || pn == 7 || pn == 8) {
        const int b = row >> 12, s = row & 4095, pos = (s & ~15) + vt_pos(s & 15);
        _Pragma("unroll") for (int bj = 0; bj < 2; ++bj) _Pragma("unroll") for (int n = 0; n < 2; ++n) {
          const int c = pn * 256 + bj * 128 + wc * 32 + n * 16 + fq * 4; const f32x4 v = acc[ai][bj][m][n] * rs;
          bf16_t* base;
          if (pn == 2) { const int cc = c - 512; base = vtsb + ((size_t)((b * 4 + (cc >> 6)) * 64 + (cc & 63))) * SEQ + pos; }
          else { const int cc = c - 1792; base = vtdf + ((size_t)((b * 4 + (cc >> 7)) * 128 + (cc & 127))) * SEQ + pos; }
          _Pragma("unroll") for (int j = 0; j < 4; ++j) base[(size_t)j * SEQ] = f2bf(v[j]);
        }
      } else if (pn >= 9) {
        bf16_t* dst = (pn == 9 ? cq : ckv) + (size_t)row * 256 + wc * 32 + fq * 4; float sq = 0.f;
        _Pragma("unroll") for (int bj = 0; bj < 2; ++bj) _Pragma("unroll") for (int n = 0; n < 2; ++n) {
          const f32x4 v = acc[ai][bj][m][n] * rs; store_bf4(dst + bj * 128 + n * 16, v);
          if (pn == 9 || bj == 0) sq += v[0] * v[0] + v[1] * v[1] + v[2] * v[2] + v[3] * v[3]; }
        sq += __shfl_xor(sq, 16); sq += __shfl_xor(sq, 32);
        if (fq == 0) (pn == 9 ? ssqq : ssqkv)[(size_t)row * 4 + wc] = sq;
      } else {
        bf16_t* dst = qkv + (size_t)row * QW + pn * 256 + wc * 32 + fq * 4;
        const bool rot = pn >= 3 && pn <= 6 && (wc & 1) == 0;
        f32x4 cs4 = {1.f, 1.f, 1.f, 1.f}, sn4 = {0.f, 0.f, 0.f, 0.f};
        if (rot) { cs4 = *(const f32x4*)(cosd + (size_t)row * 8 + (fq & 1) * 4); sn4 = *(const f32x4*)(sind + (size_t)row * 8 + (fq & 1) * 4); if (fq < 2) sn4 = -sn4; }
        _Pragma("unroll") for (int bj = 0; bj < 2; ++bj) _Pragma("unroll") for (int n = 0; n < 2; ++n) {
          f32x4 v = acc[ai][bj][m][n] * rs;
          if (n == 0 && rot) { f32x4 pr; _Pragma("unroll") for (int j = 0; j < 4; ++j) pr[j] = __shfl_xor(v[j], 32); v = v * cs4 + pr * sn4; }
          store_bf4(dst + bj * 128 + n * 16, v);
        }
      }
    )
  }
};
struct EpiUpQ {
  const float* ssqq; bf16_t* qm; const float* cosm; const float* sinm;
  __device__ __forceinline__ void operator()(const f32x4 (&acc)[2][2][4][2], const Unit& u, int wr, int wc, int fr, int fq) const {
    EPI_ROWS(
      const float rs = rsqrtf(sum4(ssqq + (size_t)row * 4) * (1.0f / 256) + EPS);
      _Pragma("unroll") for (int bj = 0; bj < 2; ++bj) {
        const int G = u.pn * 8 + bj * 4 + wc;
        if (G < 12) {
          bf16_t* dst = qm + (size_t)row * 384 + G * 32 + fq * 4;
          f32x4 x1 = acc[ai][bj][m][0] * rs, x2 = acc[ai][bj][m][1] * rs;
          if (G % 3 == 2) {
            const f32x4 c = *(const f32x4*)(cosm + (size_t)row * 16 + fq * 4), s = *(const f32x4*)(sinm + (size_t)row * 16 + fq * 4);
            const f32x4 o1 = x1 * c - x2 * s, o2 = x2 * c + x1 * s; x1 = o1; x2 = o2;
          }
          store_bf4(dst, x1); store_bf4(dst + 16, x2);
        }
      }
    )
  }
};
struct EpiUpKV {
  const float* ssqkv; bf16_t* km; bf16_t* vtml;
  __device__ __forceinline__ void operator()(const f32x4 (&acc)[2][2][4][2], const Unit& u, int wr, int wc, int fr, int fq) const {
    EPI_ROWS(
      const float rs = rsqrtf(sum4(ssqkv + (size_t)row * 4) * (1.0f / 128) + EPS);
      const int b = row >> 12, s = row & 4095, pos = (s & ~15) + vt_pos(s & 15);
      _Pragma("unroll") for (int bj = 0; bj < 2; ++bj) _Pragma("unroll") for (int n = 0; n < 2; ++n) {
        const int c = bj * 128 + wc * 32 + n * 16 + fq * 4; const f32x4 v = acc[ai][bj][m][n] * rs;
        if (u.pn == 0) store_bf4(km + (size_t)row * 384 + (c >> 6) * 96 + (c & 63), v);
        else { bf16_t* base = vtml + ((size_t)((b * 4 + (c >> 6)) * 64 + (c & 63))) * SEQ + pos;
          _Pragma("unroll") for (int j = 0; j < 4; ++j) base[(size_t)j * SEQ] = f2bf(v[j]); }
      }
    )
  }
};

constexpr int LDS_K = 0, LDS_V = 16384;

template <int DQK, int DV, bool SB>
__device__ __forceinline__ void attn_pass(LAS unsigned char* lds, const bf16_t* Qg, int ldq, const bf16_t* Kg, int ldk, const bf16_t* VTg, int q0, float sc,
                                          f32x16 (&o)[DV / 32], float& lsum) {
  constexpr int KS = (DQK + 8) * 2, VS = 144, CK = DQK / 8, NKL = (64 * CK + 511) / 512, NVL = DV / 64, NKK = DQK / 16;
  const int tid = opaque_tid(), wid = tid >> 6, lane = tid & 63, l31 = lane & 31, hh = lane >> 5;
  const int qrow = q0 + wid * 32 + l31, qmin = q0 + wid * 32, qmax = qmin + 31;
  bf16x8 qf[NKK];
#pragma unroll
  for (int kk = 0; kk < NKK; ++kk) qf[kk] = *(const bf16x8*)(Qg + (size_t)qrow * ldq + kk * 16 + hh * 8);
#pragma unroll
  for (int db = 0; db < DV / 32; ++db)
#pragma unroll
    for (int r = 0; r < 16; ++r) o[db][r] = 0.f;
  float mrun = -INFINITY, lrun = 0.f, carry = 0.f;
  const int nt = (q0 + 256) / 64;
  u32x4 kreg[NKL], vreg[NVL];
  auto gload = [&](int k0) {
#pragma unroll
    for (int i = 0; i < NKL; ++i) { const int idx = tid + i * 512; if (idx < 64 * CK) { const int row = idx / CK, ch = idx % CK; kreg[i] = *(const u32x4*)(Kg + (size_t)(k0 + row) * ldk + ch * 8); } }
#pragma unroll
    for (int i = 0; i < NVL; ++i) { const int idx = tid + i * 512; const int d = idx >> 3, ch = idx & 7; vreg[i] = *(const u32x4*)(VTg + (size_t)d * SEQ + k0 + ch * 8); }
  };
  gload(SB ? (nt - 1) * 64 : 0);
  for (int it = 0; it < nt; ++it) {
    const int k0 = (SB ? (nt - 1 - it) : it) * 64;
    if (SB) {
      const bool wdone = (k0 + 64 <= qmax) && __all(carry < -110.0f);
      if (__syncthreads_and(wdone)) break;
    } else __syncthreads();
#pragma unroll
    for (int i = 0; i < NKL; ++i) { const int idx = tid + i * 512; if (idx < 64 * CK) { const int row = idx / CK, ch = idx % CK; *(LAS u32x4*)(lds + LDS_K + row * KS + ch * 16) = kreg[i]; } }
#pragma unroll
    for (int i = 0; i < NVL; ++i) { const int idx = tid + i * 512; const int d = idx >> 3, ch = idx & 7; *(LAS u32x4*)(lds + LDS_V + d * VS + ch * 16) = vreg[i]; }
    __syncthreads();
    if (it + 1 < nt) gload((SB ? (nt - 2 - it) : (it + 1)) * 64);
    if (k0 <= qmax) {
      f32x16 s[2];
#pragma unroll
      for (int kb = 0; kb < 2; ++kb) {
#pragma unroll
        for (int r = 0; r < 16; ++r) s[kb][r] = 0.f;
#pragma unroll
        for (int kk = 0; kk < NKK; ++kk) {
          const bf16x8 a = *(const LAS bf16x8*)(lds + LDS_K + (kb * 32 + l31) * KS + (kk * 16 + hh * 8) * 2);
          s[kb] = __builtin_amdgcn_mfma_f32_32x32x16_bf16(a, qf[kk], s[kb], 0, 0, 0);
        }
      }
      const bool diag = (k0 + 63 >= qmin);
      if (!SB) {
        float mx = -INFINITY;
        if (diag) {
#pragma unroll
          for (int kb = 0; kb < 2; ++kb)
#pragma unroll
            for (int r = 0; r < 16; ++r) { const int key = k0 + kb * 32 + 8 * (r >> 2) + 4 * hh + (r & 3); if (key > qrow) s[kb][r] = -INFINITY; }
        }
#pragma unroll
        for (int kb = 0; kb < 2; ++kb)
#pragma unroll
          for (int r = 0; r < 16; ++r) mx = fmaxf(mx, s[kb][r]);
        mx = fmaxf(mx, __shfl_xor(mx, 32));
        const float mnew = fmaxf(mrun, mx);
        if (!__all(mnew == mrun)) {
          const float alpha = fexp2((mrun - mnew) * sc);
          lrun *= alpha;
#pragma unroll
          for (int db = 0; db < DV / 32; ++db)
#pragma unroll
            for (int r = 0; r < 16; ++r) o[db][r] *= alpha;
          mrun = mnew;
        }
        const float msc = -mnew * sc;
#pragma unroll
        for (int kb = 0; kb < 2; ++kb)
#pragma unroll
          for (int r = 0; r < 16; ++r) { const float pv = fexp2(__builtin_fmaf(s[kb][r], sc, msc)); s[kb][r] = pv; lrun += pv; }
      } else {
        float lk[2][16];
#pragma unroll
        for (int kb = 0; kb < 2; ++kb)
#pragma unroll
          for (int r = 0; r < 16; ++r) {
            const float z = s[kb][r] * sc;
            const float e = fexp2(-fabsf(z) * LOG2E);
            const float lb = fminf(z, 0.f) - flog2(1.0f + e) * LN2;
            bool valid = true;
            if (diag) { const int key = k0 + kb * 32 + 8 * (r >> 2) + 4 * hh + (r & 3); valid = key < qrow; }
            s[kb][r] = valid ? lb : -INFINITY; lk[kb][r] = valid ? lb - z : 0.f;
          }
        float run = carry;
#pragma unroll
        for (int kb = 1; kb >= 0; --kb)
#pragma unroll
          for (int g = 3; g >= 0; --g) {
            const float G = (lk[kb][4 * g] + lk[kb][4 * g + 1]) + (lk[kb][4 * g + 2] + lk[kb][4 * g + 3]);
            const float Gp = __shfl_xor(G, 32);
            float bt = run + (hh == 0 ? Gp : 0.f);
            s[kb][4 * g + 3] = fexp2((s[kb][4 * g + 3] + bt) * LOG2E); bt += lk[kb][4 * g + 3];
            s[kb][4 * g + 2] = fexp2((s[kb][4 * g + 2] + bt) * LOG2E); bt += lk[kb][4 * g + 2];
            s[kb][4 * g + 1] = fexp2((s[kb][4 * g + 1] + bt) * LOG2E); bt += lk[kb][4 * g + 1];
            s[kb][4 * g + 0] = fexp2((s[kb][4 * g + 0] + bt) * LOG2E);
            run += G + Gp;
          }
        carry = run;
      }
#pragma unroll
      for (int kb = 0; kb < 2; ++kb)
#pragma unroll
        for (int s2 = 0; s2 < 2; ++s2) {
          u32x4 pw;
          pw.x = cvt_pk_bf16(s[kb][8 * s2 + 0], s[kb][8 * s2 + 1]); pw.y = cvt_pk_bf16(s[kb][8 * s2 + 2], s[kb][8 * s2 + 3]);
          pw.z = cvt_pk_bf16(s[kb][8 * s2 + 4], s[kb][8 * s2 + 5]); pw.w = cvt_pk_bf16(s[kb][8 * s2 + 6], s[kb][8 * s2 + 7]);
          const bf16x8 pf = __builtin_bit_cast(bf16x8, pw);
#pragma unroll
          for (int db = 0; db < DV / 32; ++db) {
            const bf16x8 a = *(const LAS bf16x8*)(lds + LDS_V + (db * 32 + l31) * VS + (kb * 32 + s2 * 16 + hh * 8) * 2);
            o[db] = __builtin_amdgcn_mfma_f32_32x32x16_bf16(a, pf, o[db], 0, 0, 0);
          }
        }
    }
  }
  lsum = lrun + __shfl_xor(lrun, 32);
}

constexpr int LDS_OUT = 49152;
template <int NDB>
__device__ __forceinline__ void attn_store(LAS unsigned char* lds, bf16_t* mixed, int tok0w, int col0, const f32x16 (&o)[NDB], int wid, int lane) {
  constexpr int RS = NDB * 64 + 16, CPR = NDB * 4;
  LAS unsigned char* reg = lds + LDS_OUT + wid * (32 * 272);
  const int l31 = lane & 31, hh = lane >> 5;
#pragma unroll
  for (int db = 0; db < NDB; ++db)
#pragma unroll
    for (int g = 0; g < 4; ++g) {
      u32x2 w; w.x = cvt_pk_bf16(o[db][4 * g], o[db][4 * g + 1]); w.y = cvt_pk_bf16(o[db][4 * g + 2], o[db][4 * g + 3]);
      *(LAS u32x2*)(reg + l31 * RS + (db * 32 + 8 * g + 4 * hh) * 2) = w;
    }
  asm volatile("s_waitcnt lgkmcnt(0)" ::: "memory");
#pragma unroll
  for (int i = 0; i < 32 * CPR / 64; ++i) {
    const int idx = i * 64 + lane, row = idx / CPR, ch = idx % CPR;
    const u32x4 w = *(const LAS u32x4*)(reg + row * RS + ch * 16);
    *(u32x4*)(mixed + (size_t)(tok0w + row) * D + col0 + ch * 8) = w;
  }
}

__device__ const unsigned char ATT_ORDER[48] = {
  31, 30, 29, 28, 27, 26, 25, 24, 23, 22, 21, 20, 19, 18, 15, 14, 13, 12, 11, 10, 9, 8, 7, 6, 5, 4, 3, 2, 17, 1, 16, 0, 47, 46, 45, 44, 43, 42, 41, 40, 39, 38, 37, 36, 35, 34, 33, 32
};

__device__ __forceinline__ void attn_phase(const Params& p, int layer, LAS unsigned char* lds, int* ctr, unsigned* up_done) {
  bool mla_ready = false;
  LAS int* slot = (LAS int*)(lds + 40960);
  for (;;) {
    unsigned char* ws = opq(p.ws);
    const bf16_t* qkv = (const bf16_t*)(ws + WS_QKV);
    bf16_t* mixed = (bf16_t*)(ws + WS_MIX);
    const int tid = opaque_tid(), wid = tid >> 6, lane = tid & 63, l31 = lane & 31, hh = lane >> 5;
    __syncthreads();
    if (tid == 0) *slot = atomicAdd(ctr, 1);
    __syncthreads();
    const int item = *slot;
    if (item >= 768) break;
    const int e = ATT_ORDER[item >> 4], type = e >> 4, qb = e & 15, bh = item & 15, b = bh >> 2, head = bh & 3;
    const int q0 = qb * 256, tok = b * SEQ + q0 + wid * 32 + l31;
    if (type == 2 && !mla_ready) {
      if (tid == 0) { unsigned sp = 0;
        while (__hip_atomic_load(up_done, __ATOMIC_RELAXED, __HIP_MEMORY_SCOPE_AGENT) < gridDim.x) { __builtin_amdgcn_s_sleep(2); if (++sp > (1u << 22)) break; }
        __builtin_amdgcn_fence(__ATOMIC_ACQUIRE, "agent"); asm volatile("s_waitcnt vmcnt(0)" ::: "memory"); }
      __syncthreads();
      mla_ready = true;
    }
    if (type == 0) {
      f32x16 o[2]; float l;
      attn_pass<64, 64, true>(lds, qkv + (size_t)b * SEQ * QW + head * 64, QW, qkv + (size_t)b * SEQ * QW + 256 + head * 64, QW,
                              (const bf16_t*)(ws + WS_VTSB) + (size_t)bh * 64 * SEQ, q0, 0.125f, o, l);
      attn_store<2>(lds, mixed, tok - l31, head * 64, o, wid, lane);
    } else if (type == 1) {
      const float* lq1 = p.in[12] + layer * 64; const float* lk1 = p.in[13] + layer * 64; const float* lq2 = p.in[14] + layer * 64; const float* lk2 = p.in[15] + layer * 64;
      const float linit = 0.8f - 0.6f * expf(-0.3f * (float)layer);
      const float lam = expf(wave_sum(lq1[lane] * lk1[lane])) - expf(wave_sum(lq2[lane] * lk2[lane])) + linit;
      f32x16 o1[4]; float l1, l2;
      const bf16_t* vt = (const bf16_t*)(ws + WS_VTDF) + (size_t)bh * 128 * SEQ;
      f32x4* stash = (f32x4*)(ws + WS_STASH) + (size_t)blockIdx.x * 16 * 512 + tid;
      attn_pass<64, 128, false>(lds, qkv + (size_t)b * SEQ * QW + 768 + head * 128, QW, qkv + (size_t)b * SEQ * QW + 1280 + head * 128, QW, vt, q0, 0.125f * LOG2E, o1, l1);
      { const float inv = 1.0f / l1;
#pragma unroll
        for (int db = 0; db < 4; ++db)
#pragma unroll
          for (int g = 0; g < 4; ++g) { f32x4 v; v[0] = o1[db][4 * g] * inv; v[1] = o1[db][4 * g + 1] * inv; v[2] = o1[db][4 * g + 2] * inv; v[3] = o1[db][4 * g + 3] * inv; stash[(db * 4 + g) * 512] = v; } }
      attn_pass<64, 128, false>(lds, qkv + (size_t)b * SEQ * QW + 768 + head * 128 + 64, QW, qkv + (size_t)b * SEQ * QW + 1280 + head * 128 + 64, QW, vt, q0, 0.125f * LOG2E, o1, l2);
      { const float inv = lam / l2; float sq = 0.f;
#pragma unroll
        for (int db = 0; db < 4; ++db)
#pragma unroll
          for (int g = 0; g < 4; ++g) { const f32x4 a = stash[(db * 4 + g) * 512];
#pragma unroll
            for (int j = 0; j < 4; ++j) { const float v = a[j] - o1[db][4 * g + j] * inv; o1[db][4 * g + j] = v; sq += v * v; } }
        sq += __shfl_xor(sq, 32);
        const float rs = rsqrtf(sq * (1.0f / 128) + EPS) * (1.0f - linit);
        const float* gsub = p.in[16] + layer * 128;
#pragma unroll
        for (int db = 0; db < 4; ++db)
#pragma unroll
          for (int g = 0; g < 4; ++g) { const f32x4 gv = *(const f32x4*)(gsub + db * 32 + 8 * g + 4 * hh);
#pragma unroll
            for (int j = 0; j < 4; ++j) o1[db][4 * g + j] *= rs * gv[j]; } }
      attn_store<4>(lds, mixed, tok - l31, 256 + head * 128, o1, wid, lane);
    } else {
      f32x16 o[2]; float l;
      attn_pass<96, 64, false>(lds, (const bf16_t*)(ws + WS_QM) + (size_t)b * SEQ * 384 + head * 96, 384, (const bf16_t*)(ws + WS_KM) + (size_t)b * SEQ * 384 + head * 96, 384,
                               (const bf16_t*)(ws + WS_VTML) + (size_t)bh * 64 * SEQ, q0, 0.10206207261596577f * LOG2E, o, l);
      const float inv = 1.0f / l;
#pragma unroll
      for (int db = 0; db < 2; ++db)
#pragma unroll
        for (int r = 0; r < 16; ++r) o[db][r] *= inv;
      attn_store<2>(lds, mixed, tok - l31, 768 + head * 64, o, wid, lane);
    }
  }
}

struct WDesc { const float* src; bf16_t* dst; const float* gain; int K, Kpad, Nsrc, Npad, mode; };
__device__ __forceinline__ void get_wdesc(const Params& p, int layer, int kind, WDesc& d) {
  unsigned char* wl = p.ws + WS_W + (size_t)layer * SZ_WL;
  d.gain = nullptr; d.mode = 0;
  switch (kind) {
    case 0: d.src = p.in[4] + (size_t)layer * D * GU; d.dst = (bf16_t*)(wl + WO_GU1); d.gain = p.in[3] + layer * D; d.K = D; d.Kpad = D; d.Nsrc = GU; d.Npad = GU; d.mode = 1; break;
    case 1: d.src = p.in[5] + (size_t)layer * FF * D; d.dst = (bf16_t*)(wl + WO_D1); d.K = FF; d.Kpad = FF; d.Nsrc = D; d.Npad = D; break;
    case 2: d.src = p.in[7] + (size_t)layer * D * 2720; d.dst = (bf16_t*)(wl + WO_IN); d.gain = p.in[6] + layer * D; d.K = D; d.Kpad = D; d.Nsrc = 2720; d.Npad = NQ; break;
    case 3: d.src = p.in[9] + (size_t)layer * 256 * 384; d.dst = (bf16_t*)(wl + WO_UPQ); d.gain = p.in[8] + layer * 256; d.K = 256; d.Kpad = 256; d.Nsrc = 384; d.Npad = 512; break;
    case 4: d.src = p.in[11] + (size_t)layer * 128 * 512; d.dst = (bf16_t*)(wl + WO_UPKV); d.gain = p.in[10] + layer * 128; d.K = 128; d.Kpad = 256; d.Nsrc = 512; d.Npad = 512; d.mode = 2; break;
    case 5: d.src = p.in[17] + (size_t)layer * D * D; d.dst = (bf16_t*)(wl + WO_OUT); d.K = D; d.Kpad = D; d.Nsrc = D; d.Npad = D; break;
    case 6: d.src = p.in[19] + (size_t)layer * D * GU; d.dst = (bf16_t*)(wl + WO_GU2); d.gain = p.in[18] + layer * D; d.K = D; d.Kpad = D; d.Nsrc = GU; d.Npad = GU; d.mode = 1; break;
    case 7: d.src = p.in[20] + (size_t)layer * FF * D; d.dst = (bf16_t*)(wl + WO_D2); d.K = FF; d.Kpad = FF; d.Nsrc = D; d.Npad = D; break;
    case 8: d.src = p.in[22] + (size_t)layer * D * D; d.dst = (bf16_t*)(wl + WO_GATE); d.gain = p.in[21] + layer * D; d.K = D; d.Kpad = D; d.Nsrc = D; d.Npad = D; break;
    default: d.src = p.in[23] + (size_t)layer * 256 * D; d.dst = (bf16_t*)(wl + WO_PJ); d.K = 256; d.Kpad = 256; d.Nsrc = D; d.Npad = D; break;
  }
}
__device__ __forceinline__ int wsrc_col(int mode, int n, int Nsrc) {
  if (mode == 1) return ((n >> 7) & 1) * FF + (n >> 8) * 128 + (n & 127);
  if (mode == 2) return n < 256 ? (n >> 6) * 128 + (n & 63) : ((n - 256) >> 6) * 128 + 64 + (n & 63);
  return n < Nsrc ? n : -1;
}

__device__ __forceinline__ void prologue(const Params& p, LAS unsigned char* lds) {
  const int tid = opaque_tid(), nb = gridDim.x, bid = blockIdx.x;
  unsigned char* ws = p.ws;
  if (bid == 0 && tid < 64) ((int*)(ws + WS_CTR))[tid] = 0;
  { float* cosd = (float*)(ws + WS_ROPE); float* sind = cosd + T * 8; float* cosm = sind + T * 8; float* sinm = cosm + T * 16;
    const int* pos = (const int*)p.in[2];
    for (int i = bid * 512 + tid; i < T * 24; i += nb * 512) {
      int tok, j; float invf;
      if (i < T * 8) { tok = i >> 3; j = i & 7; invf = 1.0f / powf(500000.0f, (float)(2 * j) / 16.0f); }
      else { const int k = i - T * 8; tok = k >> 4; j = k & 15; invf = 1.0f / powf(500000.0f, (float)(2 * j) / 32.0f); }
      const float ang = (float)pos[tok] * invf;
      double rev = (double)ang * 0.15915494309189535; rev -= rint(rev);
      const float rr = (float)(rev * 6.283185307179586);
      const float c = __cosf(rr), s = __sinf(rr);
      if (i < T * 8) { cosd[tok * 8 + j] = c; sind[tok * 8 + j] = s; } else { cosm[tok * 16 + j] = c; sinm[tok * 16 + j] = s; }
    } }
  { const f32x4* src = (const f32x4*)p.in[1]; u32x2* dst = (u32x2*)(ws + WS_PB); const size_t n = (size_t)NL * T * 256 / 4;
    const size_t stride = (size_t)nb * 512;
    size_t i = (size_t)bid * 512 + tid;
    for (; i + 3 * stride < n; i += 4 * stride) {
      f32x4 v[4];
#pragma unroll
      for (int u = 0; u < 4; ++u) v[u] = __builtin_nontemporal_load(src + i + u * stride);
#pragma unroll
      for (int u = 0; u < 4; ++u) { u32x2 w; w.x = cvt_pk_bf16(v[u][0], v[u][1]); w.y = cvt_pk_bf16(v[u][2], v[u][3]); dst[i + u * stride] = w; }
    }
    for (; i < n; i += stride) { const f32x4 v = src[i]; u32x2 w; w.x = cvt_pk_bf16(v[0], v[1]); w.y = cvt_pk_bf16(v[2], v[3]); dst[i] = w; } }
  { const int wid = tid >> 6, lane = tid & 63; float* ssq0 = (float*)(ws + WS_SSQ); bf16_t* hb = (bf16_t*)(ws + WS_HB);
    for (int row = bid * 8 + wid; row < T; row += nb * 8) {
      float sq = 0.f;
#pragma unroll
      for (int i = 0; i < 4; ++i) { const size_t off = (size_t)row * D + i * 256 + lane * 4; const f32x4 v = *(const f32x4*)(p.in[0] + off);
        store_bf4(hb + off, v); sq += v[0] * v[0] + v[1] * v[1] + v[2] * v[2] + v[3] * v[3]; }
      sq = wave_sum(sq);
      if (lane < 16) ssq0[(size_t)row * 16 + lane] = lane == 0 ? sq : 0.f;
    } }
  { constexpr int NT_KIND[10] = {1408, 704, 704, 32, 32, 256, 1408, 704, 256, 64};
    constexpr int PER_LAYER = 5568;
    const int wid = tid >> 6, lane = tid & 63;
    for (int t = bid * 8 + wid; t < NL * PER_LAYER; t += nb * 8) {
      const int layer = t / PER_LAYER; int r = t % PER_LAYER, kind = 0;
#pragma unroll
      for (int k = 0; k < 9; ++k) { if (kind == k && r >= NT_KIND[k]) { r -= NT_KIND[k]; kind = k + 1; } }
      WDesc d; get_wdesc(p, layer, kind, d);
      const int nkt = d.Kpad / 64, n0 = (r / nkt) * 64, k0 = (r % nkt) * 64;
      const int sc = wsrc_col(d.mode, n0 + lane, d.Nsrc);
      const bool live = sc >= 0 && k0 < d.K;
      const float* sp = d.src + (size_t)k0 * d.Nsrc + (sc >= 0 ? sc : 0);
      bf16_t* dp = d.dst + (size_t)(n0 + lane) * d.Kpad + k0;
      float v[64];
#pragma unroll
      for (int e = 0; e < 64; ++e) v[e] = live ? __builtin_nontemporal_load(sp + (size_t)e * d.Nsrc) : 0.f;
      if (d.gain && live) {
#pragma unroll
        for (int e = 0; e < 64; ++e) v[e] *= d.gain[k0 + e];
      }
#pragma unroll
      for (int kc = 0; kc < 8; ++kc) {
        u32x4 w; w.x = cvt_pk_bf16(v[kc * 8 + 0], v[kc * 8 + 1]); w.y = cvt_pk_bf16(v[kc * 8 + 2], v[kc * 8 + 3]); w.z = cvt_pk_bf16(v[kc * 8 + 4], v[kc * 8 + 5]); w.w = cvt_pk_bf16(v[kc * 8 + 6], v[kc * 8 + 7]);
        *(u32x4*)(dp + kc * 8) = w;
      }
    }
  }
}

__device__ __forceinline__ void rope_sweep(const Params& p) {
  unsigned char* ws = opq(p.ws); const bf16_t* ckv = (const bf16_t*)(ws + WS_CKV); bf16_t* km = (bf16_t*)(ws + WS_KM);
  const float* cosm = (const float*)(ws + WS_ROPE) + T * 16; const float* sinm = cosm + T * 16;
  for (int tok = blockIdx.x * 512 + opaque_tid(); tok < T; tok += gridDim.x * 512) {
    const bf16_t* src = ckv + (size_t)tok * 256 + 128;
    float x[32];
#pragma unroll
    for (int q = 0; q < 4; ++q) { const u32x4 w = *(const u32x4*)(src + q * 8); const unsigned* wp = (const unsigned*)&w;
#pragma unroll
      for (int j = 0; j < 4; ++j) { x[q * 8 + 2 * j] = bf2f(wp[j] & 0xffffu); x[q * 8 + 2 * j + 1] = __uint_as_float(wp[j] & 0xffff0000u); } }
    unsigned o[16];
#pragma unroll
    for (int j = 0; j < 16; j += 2) {
      const float c0 = cosm[tok * 16 + j], s0 = sinm[tok * 16 + j], c1 = cosm[tok * 16 + j + 1], s1 = sinm[tok * 16 + j + 1];
      o[j / 2] = cvt_pk_bf16(x[j] * c0 - x[j + 16] * s0, x[j + 1] * c1 - x[j + 17] * s1);
      o[8 + j / 2] = cvt_pk_bf16(x[j + 16] * c0 + x[j] * s0, x[j + 17] * c1 + x[j + 1] * s1);
    }
#pragma unroll
    for (int h = 0; h < 4; ++h) { u32x4* dst = (u32x4*)(km + (size_t)tok * 384 + h * 96 + 64);
#pragma unroll
      for (int q = 0; q < 4; ++q) { u32x4 w; w.x = o[q * 4]; w.y = o[q * 4 + 1]; w.z = o[q * 4 + 2]; w.w = o[q * 4 + 3]; dst[q] = w; } }
  }
}

__device__ __forceinline__ void final_norm(const Params& p) {
  const int tid = opaque_tid(), wid = tid >> 6, lane = tid & 63; const float* ssq = (const float*)(p.ws + WS_SSQ); const float* gain = p.in[24];
  for (int row = blockIdx.x * 8 + wid; row < T; row += gridDim.x * 8) {
    const float rs = rsqrtf(sum16(ssq + (size_t)row * 16) * (1.0f / D) + EPS);
#pragma unroll
    for (int i = 0; i < 4; ++i) { const size_t off = (size_t)row * D + i * 256 + lane * 4; f32x4 v = load_bf4((const bf16_t*)(p.ws + WS_HB2) + off); const f32x4 g = *(const f32x4*)(gain + i * 256 + lane * 4);
      v = v * rs * g;
      *(f32x4*)(p.out + off) = v; }
  }
}

constexpr int LDS_BYTES = pg8::STAGE_BYTES + 16;

__global__ void __launch_bounds__(512) mk_forward(Params p) {
  extern __shared__ __attribute__((aligned(16))) unsigned char smem[];
  LAS unsigned char* lds = (LAS unsigned char*)smem;
  cg::grid_group grid = cg::this_grid();
  if (threadIdx.x == 0) { *(LAS u32x4*)(lds + pg8::STAGE_BYTES) = (u32x4){0u, 0u, 0u, 0u}; }
  __syncthreads();
  const XcdBarrier xbar = xcd_barrier_post((unsigned*)(p.ws + WS_BAR), (volatile LAS unsigned*)(lds + pg8::STAGE_BYTES));
  unsigned char* ws = p.ws;
  const int G = gridDim.x;

  prologue(p, lds);
  grid.sync();
  { volatile LAS unsigned* st = (volatile LAS unsigned*)(lds + pg8::STAGE_BYTES);
    if (threadIdx.x == 0) {
      unsigned* bar = (unsigned*)(p.ws + WS_BAR); unsigned nx = 0, idx = 0, per = 0; bool ok = true;
      for (unsigned j = 0; j < 16; ++j) { const unsigned c = xb_ld(&bar[XB_XCNT(j)]); if (c) { if (j < xbar.x) ++idx; ++nx; if (per == 0) per = c; else if (c != per) ok = false; } }
      ok = ok && nx == 8u && per * nx == (unsigned)G && st[2] < per;
      st[3] = ok ? (0x80000000u | (st[2] * nx + idx)) : blockIdx.x;
    }
    __syncthreads(); }
  const unsigned vbw = ((volatile LAS unsigned*)(lds + pg8::STAGE_BYTES))[3];
  const int bid0 = __builtin_amdgcn_readfirstlane((int)(vbw & 0x7fffffffu));
  const bool local_ok = __builtin_amdgcn_readfirstlane((int)(vbw >> 31)) != 0;
#define SEAM_LOCAL() do { if (local_ok) xcd_barrier_local(xbar); else xcd_barrier(xbar); } while (0)

  for (int layer = 0; layer < NL; ++layer) {
    int bid = bid0; asm volatile("" : "+s"(bid));
    pg8::StaticOrder so;
    const size_t HB1 = layer ? WS_HB2 : WS_HB;
    { unsigned char* w = opq(ws); unsigned char* wl = w + WS_W + (size_t)layer * SZ_WL; float* sA = (float*)(w + WS_SSQ); float* sB = sA + (size_t)T * 16;
      so.init(T, GU, G, bid); pg8::gemm_phase<true>(lds, pg8::Gemm{(const bf16_t*)(w + HB1), (const bf16_t*)(wl + WO_GU1), T, GU, D}, so, EpiGU{sA, (bf16_t*)(w + WS_ACT)}); }
    SEAM_LOCAL();
    { unsigned char* w = opq(ws); unsigned char* wl = w + WS_W + (size_t)layer * SZ_WL; float* sA = (float*)(w + WS_SSQ); float* sB = sA + (size_t)T * 16;
      so.init(T, D, G, bid); pg8::gemm_phase<true>(lds, pg8::Gemm{(const bf16_t*)(w + WS_ACT), (const bf16_t*)(wl + WO_D1), T, D, FF}, so, EpiResP{layer ? (const float*)nullptr : opq(p.in[0]), (const bf16_t*)(w + WS_HB2), (bf16_t*)(w + WS_HB), sB, 0.5f}); }
    xcd_barrier(xbar);
    { unsigned char* w = opq(ws); unsigned char* wl = w + WS_W + (size_t)layer * SZ_WL; float* sA = (float*)(w + WS_SSQ); float* sB = sA + (size_t)T * 16;
      so.init(T, NQ, G, bid); pg8::gemm_phase(lds, pg8::Gemm{(const bf16_t*)(w + WS_HB), (const bf16_t*)(wl + WO_IN), T, NQ, D}, so,
        EpiWin{sB, (bf16_t*)(w + WS_QKV), (bf16_t*)(w + WS_CQ), (bf16_t*)(w + WS_CKV), (bf16_t*)(w + WS_VTSB), (bf16_t*)(w + WS_VTDF),
               (float*)(w + WS_SSQQ), (float*)(w + WS_SSQKV), (const float*)(w + WS_ROPE), (const float*)(w + WS_ROPE) + T * 8}); }
    xcd_barrier(xbar);
    { unsigned char* w = opq(ws); unsigned char* wl = w + WS_W + (size_t)layer * SZ_WL;
      const float* cosm = (const float*)(w + WS_ROPE) + T * 16; const float* sinm = cosm + T * 16;
      so.init(T, 512, G, bid < G / 2 ? bid : -1); pg8::gemm_phase(lds, pg8::Gemm{(const bf16_t*)(w + WS_CQ), (const bf16_t*)(wl + WO_UPQ), T, 512, 256}, so,
        EpiUpQ{(float*)(w + WS_SSQQ), (bf16_t*)(w + WS_QM), cosm, sinm});
      so.init(T, 512, G - G / 2, bid >= G / 2 ? bid - G / 2 : -1); pg8::gemm_phase(lds, pg8::Gemm{(const bf16_t*)(w + WS_CKV), (const bf16_t*)(wl + WO_UPKV), T, 512, 256}, so,
        EpiUpKV{(float*)(w + WS_SSQKV), (bf16_t*)(w + WS_KM), (bf16_t*)(w + WS_VTML)});
      rope_sweep(p); }
    { asm volatile("s_waitcnt vmcnt(0)" ::: "memory"); __syncthreads();
      if (threadIdx.x == 0) { __builtin_amdgcn_fence(__ATOMIC_RELEASE, "agent"); asm volatile("s_waitcnt vmcnt(0)" ::: "memory");
        __hip_atomic_fetch_add((unsigned*)(opq(ws) + WS_CTR) + 16 + layer, 1u, __ATOMIC_RELAXED, __HIP_MEMORY_SCOPE_AGENT); } }
    attn_phase(p, layer, lds, (int*)(opq(ws) + WS_CTR) + layer, (unsigned*)(opq(ws) + WS_CTR) + 16 + layer);
    xcd_barrier(xbar);
    { unsigned char* w = opq(ws); unsigned char* wl = w + WS_W + (size_t)layer * SZ_WL; float* sA = (float*)(w + WS_SSQ); float* sB = sA + (size_t)T * 16;
      so.init(T, D, G, bid); pg8::gemm_phase<true>(lds, pg8::Gemm{(const bf16_t*)(w + WS_MIX), (const bf16_t*)(wl + WO_OUT), T, D, D}, so, EpiResP{(const float*)nullptr, (const bf16_t*)(w + WS_HB), (bf16_t*)(w + WS_HB), sA, 1.0f}); }
    SEAM_LOCAL();
    { unsigned char* w = opq(ws); unsigned char* wl = w + WS_W + (size_t)layer * SZ_WL; float* sA = (float*)(w + WS_SSQ); float* sB = sA + (size_t)T * 16;
      so.init(T, GU, G, bid); pg8::gemm_phase<true>(lds, pg8::Gemm{(const bf16_t*)(w + WS_HB), (const bf16_t*)(wl + WO_GU2), T, GU, D}, so, EpiGU{sA, (bf16_t*)(w + WS_ACT)});
      so.init(T, D, G - G / 2, bid >= G / 2 ? bid - G / 2 : -1); pg8::gemm_phase(lds, pg8::Gemm{(const bf16_t*)(w + WS_PB) + (size_t)layer * T * 256, (const bf16_t*)(wl + WO_PJ), T, D, 256}, so, EpiProj{(bf16_t*)(w + WS_MIX)}); }
    SEAM_LOCAL();
    { unsigned char* w = opq(ws); unsigned char* wl = w + WS_W + (size_t)layer * SZ_WL; float* sA = (float*)(w + WS_SSQ); float* sB = sA + (size_t)T * 16;
      so.init(T, D, G, bid); pg8::gemm_phase<true>(lds, pg8::Gemm{(const bf16_t*)(w + WS_ACT), (const bf16_t*)(wl + WO_D2), T, D, FF}, so, EpiResP{(const float*)nullptr, (const bf16_t*)(w + WS_HB), (bf16_t*)(w + WS_HB), sB, 0.5f}); }
    SEAM_LOCAL();
    { unsigned char* w = opq(ws); unsigned char* wl = w + WS_W + (size_t)layer * SZ_WL; float* sA = (float*)(w + WS_SSQ); float* sB = sA + (size_t)T * 16;
      so.init(T, D, G, bid); pg8::gemm_phase<true>(lds, pg8::Gemm{(const bf16_t*)(w + WS_HB), (const bf16_t*)(wl + WO_GATE), T, D, D}, so, EpiPleP{sB, (const bf16_t*)(w + WS_MIX), (const bf16_t*)(w + WS_HB), (bf16_t*)(w + WS_HB2), sA}); }
    if (layer + 1 < NL) SEAM_LOCAL(); else xcd_barrier(xbar);
  }
  final_norm(p);
}

extern "C" void kernel_launch(void* const* d_in, const int* in_sizes, int n_in, void* d_out, int out_size, void* d_ws, size_t ws_size, hipStream_t stream) {
  static int grid = 0;
  if (grid == 0) {
    int dev = 0, cus = 0, per_cu = 0;
    if (n_in != 25 || out_size != T * D || ws_size < WS_END) { fprintf(stderr, "kernel_launch: unexpected shapes (n_in %d out %d ws %zu need %zu)\n", n_in, out_size, ws_size, (size_t)WS_END); grid = -1; return; }
    (void)hipGetDevice(&dev);
    (void)hipDeviceGetAttribute(&cus, hipDeviceAttributeMultiprocessorCount, dev);
    if (hipFuncSetAttribute((const void*)mk_forward, hipFuncAttributeMaxDynamicSharedMemorySize, LDS_BYTES) != hipSuccess) { fprintf(stderr, "kernel_launch: hipFuncSetAttribute failed\n"); grid = -1; return; }
    (void)hipOccupancyMaxActiveBlocksPerMultiprocessor(&per_cu, (const void*)mk_forward, 512, LDS_BYTES);
    (void)hipGetLastError();
    if (per_cu < 1) fprintf(stderr, "kernel_launch: occupancy query says %d blocks per CU\n", per_cu);
    grid = cus;
  }
  if (grid < 0) return;
  Params p{};
  for (int i = 0; i < 25; ++i) p.in[i] = (const float*)d_in[i];
  p.out = (float*)d_out; p.ws = (unsigned char*)d_ws;
  if (hipMemsetAsync((unsigned char*)d_ws + WS_BAR, 0, XCD_BAR_WORDS * 4, stream) != hipSuccess) { fprintf(stderr, "kernel_launch: memset of the barrier words failed\n"); return; }
  void* args[] = {&p};
  hipError_t e = hipLaunchCooperativeKernel((const void*)mk_forward, dim3(grid), dim3(512), args, LDS_BYTES, stream);
  if (e != hipSuccess) fprintf(stderr, "kernel_launch: cooperative launch failed: %s (grid %d)\n", hipGetErrorString(e), grid);
}
```

```cpp
#include <hip/hip_runtime.h>
#include <hip/hip_cooperative_groups.h>
#include <cstdio>
namespace cg = cooperative_groups;

#define LAS __attribute__((address_space(3)))
typedef unsigned short bf16_t;
typedef short bf16x8 __attribute__((ext_vector_type(8)));
typedef float f32x4 __attribute__((ext_vector_type(4)));
typedef float f32x16 __attribute__((ext_vector_type(16)));
typedef unsigned u32x4 __attribute__((ext_vector_type(4)));
typedef unsigned u32x2 __attribute__((ext_vector_type(2)));

constexpr int T = 16384, SEQ = 4096, D = 1024, FF = 2816, GU = 5632, NQ = 2816, QW = 2304, NL = 4;
constexpr float EPS = 1e-6f;
constexpr float LOG2E = 1.4426950408889634f, LN2 = 0.6931471805599453f;

constexpr size_t al(size_t x) { return (x + 255) & ~(size_t)255; }
constexpr size_t SZ_WGU = (size_t)GU * D * 2, SZ_WD = (size_t)D * FF * 2, SZ_WIN = (size_t)NQ * D * 2, SZ_WUP = (size_t)512 * 256 * 2,
                 SZ_WSQ = (size_t)D * D * 2, SZ_WPJ = (size_t)D * 256 * 2;
constexpr size_t WO_GU1 = 0, WO_D1 = WO_GU1 + SZ_WGU, WO_IN = WO_D1 + SZ_WD, WO_UPQ = WO_IN + SZ_WIN, WO_UPKV = WO_UPQ + SZ_WUP,
                 WO_OUT = WO_UPKV + SZ_WUP, WO_GU2 = WO_OUT + SZ_WSQ, WO_D2 = WO_GU2 + SZ_WGU, WO_GATE = WO_D2 + SZ_WD, WO_PJ = WO_GATE + SZ_WSQ,
                 SZ_WL = WO_PJ + SZ_WPJ;
constexpr size_t WS_W = 0;
constexpr size_t WS_HB = al(WS_W + NL * SZ_WL);
constexpr size_t WS_ACT = al(WS_HB + (size_t)T * D * 2);
constexpr size_t WS_QKV = WS_ACT;
constexpr size_t WS_CQ = al(WS_QKV + (size_t)T * QW * 2);
constexpr size_t WS_CKV = al(WS_CQ + (size_t)T * 256 * 2);
constexpr size_t WS_ACT_END = al(WS_CKV + (size_t)T * 256 * 2) > al(WS_ACT + (size_t)T * FF * 2) ? al(WS_CKV + (size_t)T * 256 * 2) : al(WS_ACT + (size_t)T * FF * 2);
constexpr size_t WS_MIX = WS_ACT_END;
constexpr size_t WS_PB = al(WS_MIX + (size_t)T * D * 2);
constexpr size_t WS_VTSB = al(WS_PB + (size_t)NL * T * 256 * 2);
constexpr size_t WS_VTDF = al(WS_VTSB + (size_t)16 * 64 * SEQ * 2);
constexpr size_t WS_VTML = al(WS_VTDF + (size_t)16 * 128 * SEQ * 2);
constexpr size_t WS_QM = al(WS_VTML + (size_t)16 * 64 * SEQ * 2);
constexpr size_t WS_KM = al(WS_QM + (size_t)T * 384 * 2);
constexpr size_t WS_SSQ = al(WS_KM + (size_t)T * 384 * 2);
constexpr size_t WS_SSQQ = WS_SSQ + (size_t)2 * T * 16 * 4;
constexpr size_t WS_SSQKV = WS_SSQQ + (size_t)T * 4 * 4;
constexpr size_t WS_CTR = WS_SSQKV + (size_t)T * 4 * 4;
constexpr size_t WS_BAR = al(WS_CTR + 256);
constexpr size_t WS_ROPE = al(WS_BAR + 5504 * 4);
constexpr size_t WS_STASH = al(WS_ROPE + (size_t)T * 48 * 4);
constexpr size_t WS_END = al(WS_STASH + (size_t)256 * 16 * 512 * 16);
constexpr size_t WS_HB2 = WS_VTML;
static_assert(WS_HB2 + (size_t)T * D * 2 <= WS_SSQ, "hb2 alias overflows");

struct Params { const float* in[25]; float* out; unsigned char* ws; };

typedef __bf16 bf16x2_t __attribute__((ext_vector_type(2)));
typedef float f32x2_t __attribute__((ext_vector_type(2)));
__device__ __forceinline__ unsigned cvt_pk_bf16(float lo, float hi) { f32x2_t v = {lo, hi}; bf16x2_t b = __builtin_convertvector(v, bf16x2_t); return __builtin_bit_cast(unsigned, b); }
__device__ __forceinline__ bf16_t f2bf(float f) { unsigned u = __float_as_uint(f); u += 0x7FFFu + ((u >> 16) & 1u); return (bf16_t)(u >> 16); }
__device__ __forceinline__ float bf2f(unsigned v) { return __uint_as_float(v << 16); }
__device__ __forceinline__ float fexp2(float x) { return __builtin_amdgcn_exp2f(x); }
__device__ __forceinline__ float flog2(float x) { return __builtin_amdgcn_logf(x); }
__device__ __forceinline__ float frcp(float x) { return __builtin_amdgcn_rcpf(x); }
__device__ __forceinline__ int opaque_tid() { int t = threadIdx.x; asm volatile("" : "+v"(t)); return t; }
template <class P> __device__ __forceinline__ P* opq(P* p) { unsigned z; asm volatile("s_mov_b32 %0, 0" : "=s"(z)); return (P*)((unsigned char*)p + z); }
__device__ __forceinline__ float sum16(const float* p) { const f32x4 a = *(const f32x4*)p, b = *(const f32x4*)(p + 4), c = *(const f32x4*)(p + 8), d = *(const f32x4*)(p + 12);
  return (((a[0] + a[1]) + (a[2] + a[3])) + ((b[0] + b[1]) + (b[2] + b[3]))) + (((c[0] + c[1]) + (c[2] + c[3])) + ((d[0] + d[1]) + (d[2] + d[3]))); }
__device__ __forceinline__ float sum4(const float* p) { const f32x4 a = *(const f32x4*)p; return (a[0] + a[1]) + (a[2] + a[3]); }
__device__ __forceinline__ float row_rstd(const float* part, int row, int fq) {
  float s = sum4(part + (size_t)row * 16 + fq * 4); s += __shfl_xor(s, 16); s += __shfl_xor(s, 32); return rsqrtf(s * (1.0f / D) + EPS); }
__device__ __forceinline__ float wave_sum(float v) {
  v += __shfl_xor(v, 32); v += __shfl_xor(v, 16); v += __shfl_xor(v, 8); v += __shfl_xor(v, 4); v += __shfl_xor(v, 2); v += __shfl_xor(v, 1); return v;
}


#define XB_TMO      128
#define XB_XCNT(j)  (256  + 64 * (j))
#define XB_XSUB(j)  (1280 + 64 * (j))
#define XB_XGEN(j)  (2304 + 64 * (j))
#define XB_TOP      3328
#define XB_TOPGEN   3392
#define XB_LSUB(j)  (3456 + 64 * (j))
#define XB_LGEN(j)  (4480 + 64 * (j))
#define XCD_BAR_WORDS 5504
#define XB_SPIN_CAP (1u << 18)
__device__ __forceinline__ unsigned xb_ld(unsigned* p)              { return __hip_atomic_load(p, __ATOMIC_RELAXED, __HIP_MEMORY_SCOPE_AGENT); }
__device__ __forceinline__ unsigned xb_add(unsigned* p, unsigned v) { return __hip_atomic_fetch_add(p, v, __ATOMIC_RELAXED, __HIP_MEMORY_SCOPE_AGENT); }
__device__ __forceinline__ unsigned xb_xcc_id() { return (unsigned)__builtin_amdgcn_s_getreg((3 << 11) | 20) & 0xFu; }
#define XB_SPIN(cond, bar) do { unsigned _sp = 0; while (cond) { __builtin_amdgcn_s_sleep(1); \
    if ((++_sp & 255u) == 0u) { if (xb_ld(&(bar)[XB_TMO])) break; if (_sp > XB_SPIN_CAP) { atomicAdd(&(bar)[XB_TMO], 1u); break; } } } } while (0)
struct XcdBarrier { unsigned* bar; unsigned x; volatile LAS unsigned* st; };
__device__ __forceinline__ XcdBarrier xcd_barrier_post(unsigned* bar, volatile LAS unsigned* st) {
  XcdBarrier b; b.bar = bar; b.x = xb_xcc_id(); b.st = st;
  if (threadIdx.x == 0) st[2] = xb_add(&bar[XB_XCNT(b.x)], 1u);
  return b;
}
__device__ __forceinline__ void xcd_barrier_complete(unsigned* bar, unsigned x, unsigned& nloc, unsigned& nx) {
  const unsigned G = gridDim.x * gridDim.y * gridDim.z;
  unsigned sum, cnt, mine, sp = 0u;
  for (;;) {
    sum = 0u; cnt = 0u; mine = 0u;
#pragma unroll
    for (unsigned j = 0; j < 16; ++j) { const unsigned c = xb_ld(&bar[XB_XCNT(j)]); sum += c; cnt += (c > 0u) ? 1u : 0u; mine = (j == x) ? c : mine; }
    if (sum == G) break;
    __builtin_amdgcn_s_sleep(1);
    if ((++sp & 255u) == 0u) { if (xb_ld(&bar[XB_TMO])) break; if (sp > XB_SPIN_CAP) { atomicAdd(&bar[XB_TMO], 1u); break; } }
  }
  nloc = mine > 0u ? mine : 1u; nx = cnt > 0u ? cnt : 1u;
}
__device__ __forceinline__ void xcd_barrier(const XcdBarrier& b) {
  asm volatile("s_waitcnt vmcnt(0)" ::: "memory");
  __syncthreads();
  if (threadIdx.x == 0) {
    unsigned* bar = b.bar;
    __builtin_amdgcn_s_waitcnt(0);
    unsigned nloc = b.st[0], nx = b.st[1];
    if (nloc == 0u) { xcd_barrier_complete(bar, b.x, nloc, nx); b.st[0] = nloc; b.st[1] = nx; }
    const unsigned old = xb_add(&bar[XB_XSUB(b.x)], 1u);
    const unsigned gen = old / nloc;
    if (old + 1u == (gen + 1u) * nloc) {
      __builtin_amdgcn_fence(__ATOMIC_RELEASE, "agent");
      asm volatile("s_waitcnt vmcnt(0)" ::: "memory");
      const unsigned og = xb_add(&bar[XB_TOP], 1u);
      const unsigned tg = og / nx;
      if (og + 1u == (tg + 1u) * nx) xb_add(&bar[XB_TOPGEN], 1u);
      else XB_SPIN(xb_ld(&bar[XB_TOPGEN]) == tg, bar);
      __builtin_amdgcn_fence(__ATOMIC_ACQUIRE, "agent");
      xb_add(&bar[XB_XGEN(b.x)], 1u);
      asm volatile("s_waitcnt vmcnt(0)" ::: "memory");
    } else {
      XB_SPIN(xb_ld(&bar[XB_XGEN(b.x)]) == gen, bar);
      __builtin_amdgcn_fence(__ATOMIC_ACQUIRE, "agent");
      asm volatile("s_waitcnt vmcnt(0)" ::: "memory");
    }
  }
  __syncthreads();
}

__device__ __forceinline__ void xcd_barrier_local(const XcdBarrier& b) {
  asm volatile("s_waitcnt vmcnt(0)" ::: "memory");
  __syncthreads();
  if (threadIdx.x == 0) {
    unsigned* bar = b.bar;
    __builtin_amdgcn_s_waitcnt(0);
    unsigned nloc = b.st[0], nx = b.st[1];
    if (nloc == 0u) { xcd_barrier_complete(bar, b.x, nloc, nx); b.st[0] = nloc; b.st[1] = nx; }
    const unsigned old = xb_add(&bar[XB_LSUB(b.x)], 1u);
    const unsigned gen = old / nloc;
    if (old + 1u == (gen + 1u) * nloc) xb_add(&bar[XB_LGEN(b.x)], 1u);
    else XB_SPIN(xb_ld(&bar[XB_LGEN(b.x)]) == gen, bar);
    __builtin_amdgcn_fence(__ATOMIC_ACQUIRE, "agent");
    asm volatile("s_waitcnt vmcnt(0)" ::: "memory");
  }
  __syncthreads();
}

namespace pg8 {
constexpr int BM = 256, BK = 64, HALF = 128, HTB = HALF * BK * 2, STAGE_BYTES = 8 * HTB, NXCD = 8, WGM = 8;
__host__ __device__ __forceinline__ int lds_byte(int r, int c) { const int st = (r >> 4) * 2 + (c >> 5), rr = r & 15, cc = c & 31, ob = rr * 64 + cc * 2; return st * 1024 + (ob ^ (((ob >> 9) & 1) << 5)); }
__host__ __device__ __forceinline__ void stage_rc(int b, int& R, int& C) { const int st = b / 1024, sb = b % 1024, swz = sb ^ (((sb >> 9) & 1) << 5); R = (st >> 1) * 16 + swz / 64; C = (st & 1) * 32 + (swz % 64) / 2; }
struct Unit { int pm, pn; };
struct Gemm { const bf16_t* A; const bf16_t* Bt; int M, N, K; };
__device__ __forceinline__ void map_tile(int L, int nM, int nN, Unit& u) {
  const int nwg = nM * nN; int wgid = L;
  { const int q = nwg / NXCD, r = nwg % NXCD, xcd = wgid % NXCD, off = wgid / NXCD; wgid = (xcd < r ? xcd * (q + 1) : r * (q + 1) + (xcd - r) * q) + off; }
  const int nig = WGM * nN, gid = wgid / nig, fm = gid * WGM, gsz = (nM - fm) < WGM ? (nM - fm) : WGM;
  u.pm = fm + ((wgid % nig) % gsz); u.pn = (wgid % nig) / gsz;
}
struct StaticOrder {
  int nM, nN, nwg, G, c;
  __device__ void init(int M, int N, int G_, int c_) { nM = M / BM; nN = N / BM; nwg = nM * nN; G = G_; c = c_; }
  __device__ bool next(int i, Unit& u) const { const long L = (long)i * G + c; if (L >= nwg || c < 0) return false; map_tile((int)L, nM, nN, u); return true; }
};

__host__ __device__ __forceinline__ int perm32(int rho) { const int n = rho >> 4, i = rho & 15; return 8 * (i >> 2) + 4 * n + (i & 3); }
template <bool PERM = false, class Epi, class Sched>
__device__ __forceinline__ void gemm_phase(LAS unsigned char* lds, const Gemm g, const Sched& S, const Epi& E) {
  const int tid = opaque_tid(), wid = __builtin_amdgcn_readfirstlane(tid >> 6), lane = tid & 63, wr = wid >> 2, wc = wid & 3, fr = lane & 15, fq = lane >> 4;
  const int K = g.K, nt = K / BK;
  unsigned voffA[2], voffB[2];
#pragma unroll
  for (int i = 0; i < 2; ++i) { int R, C; stage_rc(tid * 16 + i * 8192, R, C); const int Rb = PERM ? ((R & ~31) + perm32(R & 31)) : R;
    voffA[i] = (unsigned)(R * K + C) * 2u; voffB[i] = (unsigned)(Rb * K + C) * 2u; }
  const size_t kstep = (size_t)(BK * 2);
  const size_t hstep = (size_t)HALF * K * 2;
  const size_t tstep = 2 * hstep;
  const unsigned ldsw = (unsigned)wid * 1024u;
  const int aoff = lds_byte(wr * 64 + fr, fq * 8), boff = lds_byte(wc * 32 + fr, fq * 8);
#define PG8_SA(b, h) (((b) * 2 + (h)) * HTB)
#define PG8_SB(b, h) ((4 + (b) * 2 + (h)) * HTB)
#define PG8_STAGE(bufoff, gbase, voff) do { _Pragma("unroll") for (int _i = 0; _i < 2; ++_i) \
    __builtin_amdgcn_global_load_lds((const unsigned*)((const char*)(gbase) + (voff)[_i]), (LAS unsigned*)(lds + (bufoff) + ldsw + _i * 8192), 16, 0, 0); } while (0)
#define PG8_LDA(dst, b, h) do { _Pragma("unroll") for (int m = 0; m < 4; ++m) _Pragma("unroll") for (int k = 0; k < 2; ++k) dst[m][k] = *(const LAS bf16x8*)(lds + PG8_SA(b, h) + aoff + m * 2048 + k * 1024); } while (0)
#define PG8_LDB(dst, b, h) do { _Pragma("unroll") for (int n = 0; n < 2; ++n) _Pragma("unroll") for (int k = 0; k < 2; ++k) dst[n][k] = *(const LAS bf16x8*)(lds + PG8_SB(b, h) + boff + n * 2048 + k * 1024); } while (0)
#define PG8_MMA(ai, bj, At, Bt) do { __builtin_amdgcn_s_setprio(1); _Pragma("unroll") for (int m = 0; m < 4; ++m) _Pragma("unroll") for (int n = 0; n < 2; ++n) _Pragma("unroll") for (int k = 0; k < 2; ++k) \
    acc[ai][bj][m][n] = __builtin_amdgcn_mfma_f32_16x16x32_bf16(Bt[n][k], At[m][k], acc[ai][bj][m][n], 0, 0, 0); __builtin_amdgcn_s_setprio(0); } while (0)
#define PG8_WAIT_V(n) asm volatile("s_waitcnt vmcnt(" #n ")" ::: "memory")
#define PG8_WAIT_L(n) asm volatile("s_waitcnt lgkmcnt(" #n ")" ::: "memory")
#define PG8_BAR __builtin_amdgcn_s_barrier()
#define PG8_SCHED __builtin_amdgcn_sched_barrier(0)
  Unit cur, nxt; int ui = 0;
  if (!S.next(0, cur)) return;
  f32x4 acc[2][2][4][2];
#pragma unroll
  for (int a = 0; a < 2; ++a)
#pragma unroll
    for (int b = 0; b < 2; ++b)
#pragma unroll
      for (int m = 0; m < 4; ++m)
#pragma unroll
        for (int n = 0; n < 2; ++n) acc[a][b][m][n] = (f32x4){0.f, 0.f, 0.f, 0.f};
  bf16x8 At[4][2], B0[2][2], B1[2][2];
  const char* cA = (const char*)g.A + (size_t)cur.pm * tstep; const char* cB = (const char*)g.Bt + (size_t)cur.pn * tstep;
  PG8_STAGE(PG8_SB(0, 0), cB, voffB); PG8_STAGE(PG8_SA(0, 0), cA, voffA); PG8_STAGE(PG8_SB(0, 1), cB + hstep, voffB); PG8_STAGE(PG8_SA(0, 1), cA + hstep, voffA);
  if (wr == 1) PG8_BAR;
  PG8_WAIT_V(4); PG8_BAR;
  PG8_STAGE(PG8_SB(1, 0), cB + kstep, voffB); PG8_STAGE(PG8_SA(1, 0), cA + kstep, voffA); PG8_STAGE(PG8_SB(1, 1), cB + hstep + kstep, voffB);
  PG8_WAIT_V(6); PG8_BAR;
  for (;;) {
    const bool has_next = S.next(ui + 1, nxt);
    const char* nA = has_next ? (const char*)g.A + (size_t)nxt.pm * tstep : cA; const char* nB = has_next ? (const char*)g.Bt + (size_t)nxt.pn * tstep : cB;
#pragma unroll 1
    for (int t = 0; t < nt; t += 2) {
      const bool last = (t == nt - 2);
      const char* a1 = cA + (size_t)(t + 1) * kstep;
      const char* a2 = last ? nA : cA + (size_t)(t + 2) * kstep; const char* b2 = last ? nB : cB + (size_t)(t + 2) * kstep;
      const char* a3 = a2 + kstep; const char* b3 = b2 + kstep;
      PG8_LDB(B0, 0, 0); PG8_SCHED; PG8_LDA(At, 0, 0); PG8_STAGE(PG8_SA(1, 1), a1 + hstep, voffA);
      PG8_WAIT_L(8); PG8_BAR; PG8_WAIT_L(0); PG8_MMA(0, 0, At, B0); PG8_BAR; PG8_SCHED;
      PG8_LDB(B1, 0, 1); PG8_STAGE(PG8_SB(0, 0), b2, voffB);
      PG8_BAR; PG8_WAIT_L(0); PG8_MMA(0, 1, At, B1); PG8_BAR;
      PG8_LDA(At, 0, 1); PG8_STAGE(PG8_SA(0, 0), a2, voffA);
      PG8_BAR; PG8_WAIT_L(0); PG8_MMA(1, 0, At, B0); PG8_BAR; PG8_SCHED;
      PG8_STAGE(PG8_SB(0, 1), b2 + hstep, voffB);
      PG8_WAIT_V(6); PG8_BAR; PG8_MMA(1, 1, At, B1); PG8_BAR;
      PG8_LDB(B0, 1, 0); PG8_SCHED; PG8_LDA(At, 1, 0); PG8_STAGE(PG8_SA(0, 1), a2 + hstep, voffA);
      PG8_WAIT_L(8); PG8_BAR; PG8_WAIT_L(0); PG8_MMA(0, 0, At, B0); PG8_BAR; PG8_SCHED;
      PG8_LDB(B1, 1, 1); PG8_STAGE(PG8_SB(1, 0), b3, voffB);
      PG8_BAR; PG8_WAIT_L(0); PG8_MMA(0, 1, At, B1); PG8_BAR;
      PG8_LDA(At, 1, 1); PG8_STAGE(PG8_SA(1, 0), a3, voffA);
      PG8_BAR; PG8_WAIT_L(0); PG8_MMA(1, 0, At, B0); PG8_BAR; PG8_SCHED;
      PG8_STAGE(PG8_SB(1, 1), b3 + hstep, voffB);
      PG8_WAIT_V(6); PG8_BAR; PG8_MMA(1, 1, At, B1); PG8_BAR;
    }
    E(acc, cur, wr, wc, fr, fq);
    if (!has_next) break;
#pragma unroll
    for (int a = 0; a < 2; ++a)
#pragma unroll
      for (int b = 0; b < 2; ++b)
#pragma unroll
        for (int m = 0; m < 4; ++m)
#pragma unroll
          for (int n = 0; n < 2; ++n) acc[a][b][m][n] = (f32x4){0.f, 0.f, 0.f, 0.f};
    cur = nxt; cA = nA; cB = nB; ++ui;
  }
  PG8_WAIT_V(0);
  if (wr == 0) PG8_BAR;
  PG8_BAR;
#undef PG8_SA
#undef PG8_SB
#undef PG8_STAGE
#undef PG8_LDA
#undef PG8_LDB
#undef PG8_MMA
#undef PG8_WAIT_V
#undef PG8_WAIT_L
#undef PG8_BAR
#undef PG8_SCHED
}
}
using pg8::Unit;

#define EPI_ROWS(...) _Pragma("unroll") for (int ai = 0; ai < 2; ++ai) _Pragma("unroll") for (int m = 0; m < 4; ++m) { const int row = u.pm * 256 + ai * 128 + wr * 64 + m * 16 + fr; __VA_ARGS__ }

__device__ __forceinline__ f32x4 load_bf4(const bf16_t* p) { const u32x2 w = *(const u32x2*)p; f32x4 v; v[0] = __uint_as_float(w.x << 16); v[1] = __uint_as_float(w.x & 0xffff0000u); v[2] = __uint_as_float(w.y << 16); v[3] = __uint_as_float(w.y & 0xffff0000u); return v; }
__device__ __forceinline__ void store_bf4(bf16_t* p, f32x4 v) { u32x2 w; w.x = cvt_pk_bf16(v[0], v[1]); w.y = cvt_pk_bf16(v[2], v[3]); *(u32x2*)p = w; }
__device__ __forceinline__ int vt_pos(int w) { return 8 * ((w >> 2) & 1) + 4 * (w >> 3) + (w & 3); }

__device__ __forceinline__ void load_bf8(const bf16_t* p, f32x4& a, f32x4& b) { const u32x4 w = *(const u32x4*)p;
  a[0] = __uint_as_float(w.x << 16); a[1] = __uint_as_float(w.x & 0xffff0000u); a[2] = __uint_as_float(w.y << 16); a[3] = __uint_as_float(w.y & 0xffff0000u);
  b[0] = __uint_as_float(w.z << 16); b[1] = __uint_as_float(w.z & 0xffff0000u); b[2] = __uint_as_float(w.w << 16); b[3] = __uint_as_float(w.w & 0xffff0000u); }
__device__ __forceinline__ void store_bf8(bf16_t* p, const f32x4& a, const f32x4& b) { u32x4 w; w.x = cvt_pk_bf16(a[0], a[1]); w.y = cvt_pk_bf16(a[2], a[3]); w.z = cvt_pk_bf16(b[0], b[1]); w.w = cvt_pk_bf16(b[2], b[3]); *(u32x4*)p = w; }
struct EpiGU {
  const float* ssq; bf16_t* act;
  __device__ __forceinline__ void operator()(const f32x4 (&acc)[2][2][4][2], const Unit& u, int wr, int wc, int fr, int fq) const {
    float rsv[2][4];
    _Pragma("unroll") for (int ai = 0; ai < 2; ++ai) _Pragma("unroll") for (int m = 0; m < 4; ++m) rsv[ai][m] = row_rstd(ssq, u.pm * 256 + ai * 128 + wr * 64 + m * 16 + fr, fq);
    EPI_ROWS(
      const float rs = rsv[ai][m];
      f32x4 o[2];
      _Pragma("unroll") for (int n = 0; n < 2; ++n) {
        const f32x4 g = acc[ai][0][m][n] * rs, v = acc[ai][1][m][n] * rs;
        _Pragma("unroll") for (int j = 0; j < 4; ++j) o[n][j] = g[j] * frcp(1.0f + fexp2(-g[j] * LOG2E)) * v[j]; }
      store_bf8(act + (size_t)row * FF + u.pn * 128 + wc * 32 + fq * 8, o[0], o[1]);
    )
  }
};
struct EpiRes {
  const float* rin_f; const bf16_t* rin_b; bf16_t* hb; float* ssq_out; float scale;
  __device__ __forceinline__ void operator()(const f32x4 (&acc)[2][2][4][2], const Unit& u, int wr, int wc, int fr, int fq) const {
    EPI_ROWS(
      const size_t off = (size_t)row * D + u.pn * 256 + wc * 32 + fq * 4; float sq = 0.f;
      _Pragma("unroll") for (int bj = 0; bj < 2; ++bj) _Pragma("unroll") for (int n = 0; n < 2; ++n) {
        const size_t o2 = off + bj * 128 + n * 16;
        f32x4 hv = rin_f ? *(const f32x4*)(rin_f + o2) : load_bf4(rin_b + o2); hv += acc[ai][bj][m][n] * scale;
        store_bf4(hb + o2, hv);
        sq += hv[0] * hv[0] + hv[1] * hv[1] + hv[2] * hv[2] + hv[3] * hv[3]; }
      sq += __shfl_xor(sq, 16); sq += __shfl_xor(sq, 32);
      if (fq == 0) ssq_out[(size_t)row * 16 + u.pn * 4 + wc] = sq;
    )
  }
};
struct EpiPle {
  const float* ssq_in; const bf16_t* proj; const bf16_t* rin; bf16_t* hb; float* ssq_out;
  __device__ __forceinline__ void operator()(const f32x4 (&acc)[2][2][4][2], const Unit& u, int wr, int wc, int fr, int fq) const {
    EPI_ROWS(
      const float rs = rsqrtf(sum16(ssq_in + (size_t)row * 16) * (1.0f / D) + EPS);
      const size_t off = (size_t)row * D + u.pn * 256 + wc * 32 + fq * 4; float sq = 0.f;
      _Pragma("unroll") for (int bj = 0; bj < 2; ++bj) _Pragma("unroll") for (int n = 0; n < 2; ++n) {
        const size_t o2 = off + bj * 128 + n * 16;
        f32x4 hv = load_bf4(rin + o2); const f32x4 pr = load_bf4(proj + o2);
        _Pragma("unroll") for (int j = 0; j < 4; ++j) { const float gt = frcp(1.0f + fexp2(-acc[ai][bj][m][n][j] * rs * LOG2E)); hv[j] += pr[j] * gt; }
        store_bf4(hb + o2, hv);
        sq += hv[0] * hv[0] + hv[1] * hv[1] + hv[2] * hv[2] + hv[3] * hv[3]; }
      sq += __shfl_xor(sq, 16); sq += __shfl_xor(sq, 32);
      if (fq == 0) ssq_out[(size_t)row * 16 + u.pn * 4 + wc] = sq;
    )
  }
};
__device__ __forceinline__ void unpack_bf8(const u32x4& w, f32x4& a, f32x4& b) {
  a[0] = __uint_as_float(w.x << 16); a[1] = __uint_as_float(w.x & 0xffff0000u); a[2] = __uint_as_float(w.y << 16); a[3] = __uint_as_float(w.y & 0xffff0000u);
  b[0] = __uint_as_float(w.z << 16); b[1] = __uint_as_float(w.z & 0xffff0000u); b[2] = __uint_as_float(w.w << 16); b[3] = __uint_as_float(w.w & 0xffff0000u); }
struct EpiResP {
  const float* rin_f; const bf16_t* rin_b; bf16_t* hb; float* ssq_out; float scale;
  __device__ __forceinline__ void operator()(const f32x4 (&acc)[2][2][4][2], const Unit& u, int wr, int wc, int fr, int fq) const {
    _Pragma("unroll") for (int ai = 0; ai < 2; ++ai) {
      const size_t off0 = (size_t)(u.pm * 256 + ai * 128 + wr * 64 + fr) * D + u.pn * 256 + wc * 32 + fq * 8;
      f32x4 h0[4][2]; f32x4 h1[4][2];
      if (rin_f) {
        _Pragma("unroll") for (int m = 0; m < 4; ++m) _Pragma("unroll") for (int bj = 0; bj < 2; ++bj) {
          const size_t o2 = off0 + (size_t)m * 16 * D + bj * 128; h0[m][bj] = *(const f32x4*)(rin_f + o2); h1[m][bj] = *(const f32x4*)(rin_f + o2 + 4); }
      } else {
        u32x4 w[4][2];
        _Pragma("unroll") for (int m = 0; m < 4; ++m) _Pragma("unroll") for (int bj = 0; bj < 2; ++bj) w[m][bj] = *(const u32x4*)(rin_b + off0 + (size_t)m * 16 * D + bj * 128);
        _Pragma("unroll") for (int m = 0; m < 4; ++m) _Pragma("unroll") for (int bj = 0; bj < 2; ++bj) unpack_bf8(w[m][bj], h0[m][bj], h1[m][bj]);
      }
      _Pragma("unroll") for (int m = 0; m < 4; ++m) {
        const int row = u.pm * 256 + ai * 128 + wr * 64 + m * 16 + fr; float sq = 0.f;
        _Pragma("unroll") for (int bj = 0; bj < 2; ++bj) {
          f32x4 a = h0[m][bj] + acc[ai][bj][m][0] * scale, b = h1[m][bj] + acc[ai][bj][m][1] * scale;
          store_bf8(hb + off0 + (size_t)m * 16 * D + bj * 128, a, b);
          sq += (a[0] * a[0] + a[1] * a[1] + a[2] * a[2] + a[3] * a[3]) + (b[0] * b[0] + b[1] * b[1] + b[2] * b[2] + b[3] * b[3]); }
        sq += __shfl_xor(sq, 16); sq += __shfl_xor(sq, 32);
        if (fq == 0) ssq_out[(size_t)row * 16 + u.pn * 4 + wc] = sq;
      }
    }
  }
};
struct EpiPleP {
  const float* ssq_in; const bf16_t* proj; const bf16_t* rin; bf16_t* hb; float* ssq_out;
  __device__ __forceinline__ void operator()(const f32x4 (&acc)[2][2][4][2], const Unit& u, int wr, int wc, int fr, int fq) const {
    _Pragma("unroll") for (int ai = 0; ai < 2; ++ai) {
      const size_t off0 = (size_t)(u.pm * 256 + ai * 128 + wr * 64 + fr) * D + u.pn * 256 + wc * 32 + fq * 8;
      float rsv[4];
      _Pragma("unroll") for (int m = 0; m < 4; ++m) rsv[m] = row_rstd(ssq_in, u.pm * 256 + ai * 128 + wr * 64 + m * 16 + fr, fq);
      u32x4 wr_[4][2]; u32x4 wp[4][2];
      _Pragma("unroll") for (int m = 0; m < 4; ++m) _Pragma("unroll") for (int bj = 0; bj < 2; ++bj) {
        const size_t o2 = off0 + (size_t)m * 16 * D + bj * 128; wr_[m][bj] = *(const u32x4*)(rin + o2); wp[m][bj] = *(const u32x4*)(proj + o2); }
      _Pragma("unroll") for (int m = 0; m < 4; ++m) {
        const int row = u.pm * 256 + ai * 128 + wr * 64 + m * 16 + fr; float sq = 0.f;
        const float rs = rsv[m];
        _Pragma("unroll") for (int bj = 0; bj < 2; ++bj) {
          f32x4 h0; f32x4 h1; f32x4 p0; f32x4 p1; unpack_bf8(wr_[m][bj], h0, h1); unpack_bf8(wp[m][bj], p0, p1);
          _Pragma("unroll") for (int j = 0; j < 4; ++j) {
            h0[j] += p0[j] * frcp(1.0f + fexp2(-acc[ai][bj][m][0][j] * rs * LOG2E));
            h1[j] += p1[j] * frcp(1.0f + fexp2(-acc[ai][bj][m][1][j] * rs * LOG2E)); }
          store_bf8(hb + off0 + (size_t)m * 16 * D + bj * 128, h0, h1);
          sq += (h0[0] * h0[0] + h0[1] * h0[1] + h0[2] * h0[2] + h0[3] * h0[3]) + (h1[0] * h1[0] + h1[1] * h1[1] + h1[2] * h1[2] + h1[3] * h1[3]); }
        sq += __shfl_xor(sq, 16); sq += __shfl_xor(sq, 32);
        if (fq == 0) ssq_out[(size_t)row * 16 + u.pn * 4 + wc] = sq;
      }
    }
  }
};
struct EpiProj {
  bf16_t* proj;
  __device__ __forceinline__ void operator()(const f32x4 (&acc)[2][2][4][2], const Unit& u, int wr, int wc, int fr, int fq) const {
    EPI_ROWS(
      const size_t off = (size_t)row * D + u.pn * 256 + wc * 32 + fq * 4;
      _Pragma("unroll") for (int bj = 0; bj < 2; ++bj) _Pragma("unroll") for (int n = 0; n < 2; ++n) store_bf4(proj + off + bj * 128 + n * 16, acc[ai][bj][m][n]);
    )
  }
};
struct EpiWin {
  const float* ssq_in; bf16_t* qkv; bf16_t* cq; bf16_t* ckv; bf16_t* vtsb; bf16_t* vtdf; float* ssqq; float* ssqkv; const float* cosd; const float* sind;
  __device__ __forceinline__ void operator()(const f32x4 (&acc)[2][2][4][2], const Unit& u, int wr, int wc, int fr, int fq) const {
    const int pn = u.pn;
    float rsv[2][4];
    _Pragma("unroll") for (int ai = 0; ai < 2; ++ai) _Pragma("unroll") for (int m = 0; m < 4; ++m) rsv[ai][m] = row_rstd(ssq_in, u.pm * 256 + ai * 128 + wr * 64 + m * 16 + fr, fq);
    EPI_ROWS(
      const float rs = rsv[ai][m];
      if (pn == 2 || pn == 7 || pn == 8) {
        const int b = row >> 12, s = row & 4095, pos = (s & ~15) + vt_pos(s & 15);
        _Pragma("unroll") for (int bj = 0; bj < 2; ++bj) _Pragma("unroll") for (int n = 0; n < 2; ++n) {
          const int c = pn * 256 + bj * 128 + wc * 32 + n * 16 + fq * 4; const f32x4 v = acc[ai][bj][m][n] * rs;
          bf16_t* base;
          if (pn == 2) { const int cc = c - 512; base = vtsb + ((size_t)((b * 4 + (cc >> 6)) * 64 + (cc & 63))) * SEQ + pos; }
          else { const int cc = c - 1792; base = vtdf + ((size_t)((b * 4 + (cc >> 7)) * 128 + (cc & 127))) * SEQ + pos; }
          _Pragma("unroll") for (int j = 0; j < 4; ++j) base[(size_t)j * SEQ] = f2bf(v[j]);
        }
      } else if (pn >= 9) {
        bf16_t* dst = (pn == 9 ? cq : ckv) + (size_t)row * 256 + wc * 32 + fq * 4; float sq = 0.f;
        _Pragma("unroll") for (int bj = 0; bj < 2; ++bj) _Pragma("unroll") for (int n = 0; n < 2; ++n) {
          const f32x4 v = acc[ai][bj][m][n] * rs; store_bf4(dst + bj * 128 + n * 16, v);
          if (pn == 9 || bj == 0) sq += v[0] * v[0] + v[1] * v[1] + v[2] * v[2] + v[3] * v[3]; }
        sq += __shfl_xor(sq, 16); sq += __shfl_xor(sq, 32);
        if (fq == 0) (pn == 9 ? ssqq : ssqkv)[(size_t)row * 4 + wc] = sq;
      } else {
        bf16_t* dst = qkv + (size_t)row * QW + pn * 256 + wc * 32 + fq * 4;
        const bool rot = pn >= 3 && pn <= 6 && (wc & 1) == 0;
        f32x4 cs4 = {1.f, 1.f, 1.f, 1.f}, sn4 = {0.f, 0.f, 0.f, 0.f};
        if (rot) { cs4 = *(const f32x4*)(cosd + (size_t)row * 8 + (fq & 1) * 4); sn4 = *(const f32x4*)(sind + (size_t)row * 8 + (fq & 1) * 4); if (fq < 2) sn4 = -sn4; }
        _Pragma("unroll") for (int bj = 0; bj < 2; ++bj) _Pragma("unroll") for (int n = 0; n < 2; ++n) {
          f32x4 v = acc[ai][bj][m][n] * rs;
          if (n == 0 && rot) { f32x4 pr; _Pragma("unroll") for (int j = 0; j < 4; ++j) pr[j] = __shfl_xor(v[j], 32); v = v * cs4 + pr * sn4; }
          store_bf4(dst + bj * 128 + n * 16, v);
        }
      }
    )
  }
};
struct EpiUpQ {
  const float* ssqq; bf16_t* qm; const float* cosm; const float* sinm;
  __device__ __forceinline__ void operator()(const f32x4 (&acc)[2][2][4][2], const Unit& u, int wr, int wc, int fr, int fq) const {
    float rsv[2][4];
    _Pragma("unroll") for (int ai = 0; ai < 2; ++ai) _Pragma("unroll") for (int m = 0; m < 4; ++m) rsv[ai][m] = rsqrtf(sum4(ssqq + (size_t)(u.pm * 256 + ai * 128 + wr * 64 + m * 16 + fr) * 4) * (1.0f / 256) + EPS);
    EPI_ROWS(
      const float rs = rsv[ai][m];
      _Pragma("unroll") for (int bj = 0; bj < 2; ++bj) {
        const int G = u.pn * 8 + bj * 4 + wc;
        if (G < 12) {
          bf16_t* dst = qm + (size_t)row * 384 + G * 32 + fq * 4;
          f32x4 x1 = acc[ai][bj][m][0] * rs, x2 = acc[ai][bj][m][1] * rs;
          if (G % 3 == 2) {
            const f32x4 c = *(const f32x4*)(cosm + (size_t)row * 16 + fq * 4), s = *(const f32x4*)(sinm + (size_t)row * 16 + fq * 4);
            const f32x4 o1 = x1 * c - x2 * s, o2 = x2 * c + x1 * s; x1 = o1; x2 = o2;
          }
          store_bf4(dst, x1); store_bf4(dst + 16, x2);
        }
      }
    )
  }
};
struct EpiUpKV {
  const float* ssqkv; bf16_t* km; bf16_t* vtml;
  __device__ __forceinline__ void operator()(const f32x4 (&acc)[2][2][4][2], const Unit& u, int wr, int wc, int fr, int fq) const {
    float rsv[2][4];
    _Pragma("unroll") for (int ai = 0; ai < 2; ++ai) _Pragma("unroll") for (int m = 0; m < 4; ++m) rsv[ai][m] = rsqrtf(sum4(ssqkv + (size_t)(u.pm * 256 + ai * 128 + wr * 64 + m * 16 + fr) * 4) * (1.0f / 128) + EPS);
    EPI_ROWS(
      const float rs = rsv[ai][m];
      const int b = row >> 12, s = row & 4095, pos = (s & ~15) + vt_pos(s & 15);
      _Pragma("unroll") for (int bj = 0; bj < 2; ++bj) _Pragma("unroll") for (int n = 0; n < 2; ++n) {
        const int c = bj * 128 + wc * 32 + n * 16 + fq * 4; const f32x4 v = acc[ai][bj][m][n] * rs;
        if (u.pn == 0) store_bf4(km + (size_t)row * 384 + (c >> 6) * 96 + (c & 63), v);
        else { bf16_t* base = vtml + ((size_t)((b * 4 + (c >> 6)) * 64 + (c & 63))) * SEQ + pos;
          _Pragma("unroll") for (int j = 0; j < 4; ++j) base[(size_t)j * SEQ] = f2bf(v[j]); }
      }
    )
  }
};

constexpr int LDS_K = 0, LDS_V = 16384;

template <int DQK, int DV, bool SB>
__device__ __forceinline__ void attn_pass(LAS unsigned char* lds, const bf16_t* Qg, int ldq, const bf16_t* Kg, int ldk, const bf16_t* VTg, int q0, float sc,
                                          f32x16 (&o)[DV / 32], float& lsum) {
  constexpr int KS = (DQK + 8) * 2, VS = 144, CK = DQK / 8, NKL = (64 * CK + 511) / 512, NVL = DV / 64, NKK = DQK / 16;
  const int tid = opaque_tid(), wid = tid >> 6, lane = tid & 63, l31 = lane & 31, hh = lane >> 5;
  const int qrow = q0 + wid * 32 + l31, qmin = q0 + wid * 32, qmax = qmin + 31;
  bf16x8 qf[NKK];
#pragma unroll
  for (int kk = 0; kk < NKK; ++kk) qf[kk] = *(const bf16x8*)(Qg + (size_t)qrow * ldq + kk * 16 + hh * 8);
#pragma unroll
  for (int db = 0; db < DV / 32; ++db)
#pragma unroll
    for (int r = 0; r < 16; ++r) o[db][r] = 0.f;
  float mrun = -INFINITY, lrun = 0.f, carry = 0.f;
  const int nt = (q0 + 256) / 64;
  u32x4 kreg[NKL], vreg[NVL];
  auto gload = [&](int k0) {
#pragma unroll
    for (int i = 0; i < NKL; ++i) { const int idx = tid + i * 512; if (idx < 64 * CK) { const int row = idx / CK, ch = idx % CK; kreg[i] = *(const u32x4*)(Kg + (size_t)(k0 + row) * ldk + ch * 8); } }
#pragma unroll
    for (int i = 0; i < NVL; ++i) { const int idx = tid + i * 512; const int d = idx >> 3, ch = idx & 7; vreg[i] = *(const u32x4*)(VTg + (size_t)d * SEQ + k0 + ch * 8); }
  };
  gload(SB ? (nt - 1) * 64 : 0);
  for (int it = 0; it < nt; ++it) {
    const int k0 = (SB ? (nt - 1 - it) : it) * 64;
    if (SB) {
      const bool wdone = (k0 + 64 <= qmax) && __all(carry < -110.0f);
      if (__syncthreads_and(wdone)) break;
    } else __syncthreads();
#pragma unroll
    for (int i = 0; i < NKL; ++i) { const int idx = tid + i * 512; if (idx < 64 * CK) { const int row = idx / CK, ch = idx % CK; *(LAS u32x4*)(lds + LDS_K + row * KS + ch * 16) = kreg[i]; } }
#pragma unroll
    for (int i = 0; i < NVL; ++i) { const int idx = tid + i * 512; const int d = idx >> 3, ch = idx & 7; *(LAS u32x4*)(lds + LDS_V + d * VS + ch * 16) = vreg[i]; }
    __syncthreads();
    if (it + 1 < nt) gload((SB ? (nt - 2 - it) : (it + 1)) * 64);
    if (k0 <= qmax) {
      f32x16 s[2];
#pragma unroll
      for (int kb = 0; kb < 2; ++kb) {
#pragma unroll
        for (int r = 0; r < 16; ++r) s[kb][r] = 0.f;
#pragma unroll
        for (int kk = 0; kk < NKK; ++kk) {
          const bf16x8 a = *(const LAS bf16x8*)(lds + LDS_K + (kb * 32 + l31) * KS + (kk * 16 + hh * 8) * 2);
          s[kb] = __builtin_amdgcn_mfma_f32_32x32x16_bf16(a, qf[kk], s[kb], 0, 0, 0);
        }
      }
      const bool diag = (k0 + 63 >= qmin);
      if (!SB) {
        float mx = -INFINITY;
        if (diag) {
#pragma unroll
          for (int kb = 0; kb < 2; ++kb)
#pragma unroll
            for (int r = 0; r < 16; ++r) { const int key = k0 + kb * 32 + 8 * (r >> 2) + 4 * hh + (r & 3); if (key > qrow) s[kb][r] = -INFINITY; }
        }
#pragma unroll
        for (int kb = 0; kb < 2; ++kb)
#pragma unroll
          for (int r = 0; r < 16; ++r) mx = fmaxf(mx, s[kb][r]);
        mx = fmaxf(mx, __shfl_xor(mx, 32));
        const float mnew = fmaxf(mrun, mx);
        if (!__all(mnew == mrun)) {
          const float alpha = fexp2((mrun - mnew) * sc);
          lrun *= alpha;
#pragma unroll
          for (int db = 0; db < DV / 32; ++db)
#pragma unroll
            for (int r = 0; r < 16; ++r) o[db][r] *= alpha;
          mrun = mnew;
        }
        const float msc = -mnew * sc;
#pragma unroll
        for (int kb = 0; kb < 2; ++kb)
#pragma unroll
          for (int r = 0; r < 16; ++r) { const float pv = fexp2(__builtin_fmaf(s[kb][r], sc, msc)); s[kb][r] = pv; lrun += pv; }
      } else {
        float lk[2][16];
#pragma unroll
        for (int kb = 0; kb < 2; ++kb)
#pragma unroll
          for (int r = 0; r < 16; ++r) {
            const float z = s[kb][r] * sc;
            const float e = fexp2(-fabsf(z) * LOG2E);
            const float lb = fminf(z, 0.f) - flog2(1.0f + e) * LN2;
            bool valid = true;
            if (diag) { const int key = k0 + kb * 32 + 8 * (r >> 2) + 4 * hh + (r & 3); valid = key < qrow; }
            s[kb][r] = valid ? lb : -INFINITY; lk[kb][r] = valid ? lb - z : 0.f;
          }
        float run = carry;
#pragma unroll
        for (int kb = 1; kb >= 0; --kb)
#pragma unroll
          for (int g = 3; g >= 0; --g) {
            const float G = (lk[kb][4 * g] + lk[kb][4 * g + 1]) + (lk[kb][4 * g + 2] + lk[kb][4 * g + 3]);
            const float Gp = __shfl_xor(G, 32);
            float bt = run + (hh == 0 ? Gp : 0.f);
            s[kb][4 * g + 3] = fexp2((s[kb][4 * g + 3] + bt) * LOG2E); bt += lk[kb][4 * g + 3];
            s[kb][4 * g + 2] = fexp2((s[kb][4 * g + 2] + bt) * LOG2E); bt += lk[kb][4 * g + 2];
            s[kb][4 * g + 1] = fexp2((s[kb][4 * g + 1] + bt) * LOG2E); bt += lk[kb][4 * g + 1];
            s[kb][4 * g + 0] = fexp2((s[kb][4 * g + 0] + bt) * LOG2E);
            run += G + Gp;
          }
        carry = run;
      }
#pragma unroll
      for (int kb = 0; kb < 2; ++kb)
#pragma unroll
        for (int s2 = 0; s2 < 2; ++s2) {
          u32x4 pw;
          pw.x = cvt_pk_bf16(s[kb][8 * s2 + 0], s[kb][8 * s2 + 1]); pw.y = cvt_pk_bf16(s[kb][8 * s2 + 2], s[kb][8 * s2 + 3]);
          pw.z = cvt_pk_bf16(s[kb][8 * s2 + 4], s[kb][8 * s2 + 5]); pw.w = cvt_pk_bf16(s[kb][8 * s2 + 6], s[kb][8 * s2 + 7]);
          const bf16x8 pf = __builtin_bit_cast(bf16x8, pw);
#pragma unroll
          for (int db = 0; db < DV / 32; ++db) {
            const bf16x8 a = *(const LAS bf16x8*)(lds + LDS_V + (db * 32 + l31) * VS + (kb * 32 + s2 * 16 + hh * 8) * 2);
            o[db] = __builtin_amdgcn_mfma_f32_32x32x16_bf16(a, pf, o[db], 0, 0, 0);
          }
        }
    }
  }
  lsum = lrun + __shfl_xor(lrun, 32);
}

constexpr int LDS_OUT = 49152;
template <int NDB>
__device__ __forceinline__ void attn_store(LAS unsigned char* lds, bf16_t* mixed, int tok0w, int col0, const f32x16 (&o)[NDB], int wid, int lane) {
  constexpr int RS = NDB * 64 + 16, CPR = NDB * 4;
  LAS unsigned char* reg = lds + LDS_OUT + wid * (32 * 272);
  const int l31 = lane & 31, hh = lane >> 5;
#pragma unroll
  for (int db = 0; db < NDB; ++db)
#pragma unroll
    for (int g = 0; g < 4; ++g) {
      u32x2 w; w.x = cvt_pk_bf16(o[db][4 * g], o[db][4 * g + 1]); w.y = cvt_pk_bf16(o[db][4 * g + 2], o[db][4 * g + 3]);
      *(LAS u32x2*)(reg + l31 * RS + (db * 32 + 8 * g + 4 * hh) * 2) = w;
    }
  asm volatile("s_waitcnt lgkmcnt(0)" ::: "memory");
#pragma unroll
  for (int i = 0; i < 32 * CPR / 64; ++i) {
    const int idx = i * 64 + lane, row = idx / CPR, ch = idx % CPR;
    const u32x4 w = *(const LAS u32x4*)(reg + row * RS + ch * 16);
    *(u32x4*)(mixed + (size_t)(tok0w + row) * D + col0 + ch * 8) = w;
  }
}

__device__ const unsigned char ATT_ORDER[48] = {
  31, 30, 29, 28, 27, 26, 25, 24, 23, 22, 21, 20, 19, 18, 15, 14, 13, 12, 11, 10, 9, 8, 7, 6, 5, 4, 3, 2, 17, 1, 16, 0, 47, 46, 45, 44, 43, 42, 41, 40, 39, 38, 37, 36, 35, 34, 33, 32
};

__device__ __forceinline__ void attn_phase(const Params& p, int layer, LAS unsigned char* lds, int* ctr, unsigned* up_done) {
  bool mla_ready = false;
  LAS int* slot = (LAS int*)(lds + 40960);
  for (;;) {
    unsigned char* ws = opq(p.ws);
    const bf16_t* qkv = (const bf16_t*)(ws + WS_QKV);
    bf16_t* mixed = (bf16_t*)(ws + WS_MIX);
    const int tid = opaque_tid(), wid = tid >> 6, lane = tid & 63, l31 = lane & 31, hh = lane >> 5;
    __syncthreads();
    if (tid == 0) *slot = atomicAdd(ctr, 1);
    __syncthreads();
    const int item = *slot;
    if (item >= 768) break;
    const int e = ATT_ORDER[item >> 4], type = e >> 4, qb = e & 15, bh = item & 15, b = bh >> 2, head = bh & 3;
    const int q0 = qb * 256, tok = b * SEQ + q0 + wid * 32 + l31;
    if (type == 2 && !mla_ready) {
      if (tid == 0) { unsigned sp = 0;
        while (__hip_atomic_load(up_done, __ATOMIC_RELAXED, __HIP_MEMORY_SCOPE_AGENT) < gridDim.x) { __builtin_amdgcn_s_sleep(2); if (++sp > (1u << 22)) break; }
        __builtin_amdgcn_fence(__ATOMIC_ACQUIRE, "agent"); asm volatile("s_waitcnt vmcnt(0)" ::: "memory"); }
      __syncthreads();
      mla_ready = true;
    }
    if (type == 0) {
      f32x16 o[2]; float l;
      attn_pass<64, 64, true>(lds, qkv + (size_t)b * SEQ * QW + head * 64, QW, qkv + (size_t)b * SEQ * QW + 256 + head * 64, QW,
                              (const bf16_t*)(ws + WS_VTSB) + (size_t)bh * 64 * SEQ, q0, 0.125f, o, l);
      attn_store<2>(lds, mixed, tok - l31, head * 64, o, wid, lane);
    } else if (type == 1) {
      const float* lq1 = p.in[12] + layer * 64; const float* lk1 = p.in[13] + layer * 64; const float* lq2 = p.in[14] + layer * 64; const float* lk2 = p.in[15] + layer * 64;
      const float linit = 0.8f - 0.6f * expf(-0.3f * (float)layer);
      const float lam = expf(wave_sum(lq1[lane] * lk1[lane])) - expf(wave_sum(lq2[lane] * lk2[lane])) + linit;
      f32x16 o1[4]; float l1, l2;
      const bf16_t* vt = (const bf16_t*)(ws + WS_VTDF) + (size_t)bh * 128 * SEQ;
      f32x4* stash = (f32x4*)(ws + WS_STASH) + (size_t)blockIdx.x * 16 * 512 + tid;
      attn_pass<64, 128, false>(lds, qkv + (size_t)b * SEQ * QW + 768 + head * 128, QW, qkv + (size_t)b * SEQ * QW + 1280 + head * 128, QW, vt, q0, 0.125f * LOG2E, o1, l1);
      { const float inv = 1.0f / l1;
#pragma unroll
        for (int db = 0; db < 4; ++db)
#pragma unroll
          for (int g = 0; g < 4; ++g) { f32x4 v; v[0] = o1[db][4 * g] * inv; v[1] = o1[db][4 * g + 1] * inv; v[2] = o1[db][4 * g + 2] * inv; v[3] = o1[db][4 * g + 3] * inv; stash[(db * 4 + g) * 512] = v; } }
      attn_pass<64, 128, false>(lds, qkv + (size_t)b * SEQ * QW + 768 + head * 128 + 64, QW, qkv + (size_t)b * SEQ * QW + 1280 + head * 128 + 64, QW, vt, q0, 0.125f * LOG2E, o1, l2);
      { const float inv = lam / l2; float sq = 0.f;
#pragma unroll
        for (int db = 0; db < 4; ++db)
#pragma unroll
          for (int g = 0; g < 4; ++g) { const f32x4 a = stash[(db * 4 + g) * 512];
#pragma unroll
            for (int j = 0; j < 4; ++j) { const float v = a[j] - o1[db][4 * g + j] * inv; o1[db][4 * g + j] = v; sq += v * v; } }
        sq += __shfl_xor(sq, 32);
        const float rs = rsqrtf(sq * (1.0f / 128) + EPS) * (1.0f - linit);
        const float* gsub = p.in[16] + layer * 128;
#pragma unroll
        for (int db = 0; db < 4; ++db)
#pragma unroll
          for (int g = 0; g < 4; ++g) { const f32x4 gv = *(const f32x4*)(gsub + db * 32 + 8 * g + 4 * hh);
#pragma unroll
            for (int j = 0; j < 4; ++j) o1[db][4 * g + j] *= rs * gv[j]; } }
      attn_store<4>(lds, mixed, tok - l31, 256 + head * 128, o1, wid, lane);
    } else {
      f32x16 o[2]; float l;
      attn_pass<96, 64, false>(lds, (const bf16_t*)(ws + WS_QM) + (size_t)b * SEQ * 384 + head * 96, 384, (const bf16_t*)(ws + WS_KM) + (size_t)b * SEQ * 384 + head * 96, 384,
                               (const bf16_t*)(ws + WS_VTML) + (size_t)bh * 64 * SEQ, q0, 0.10206207261596577f * LOG2E, o, l);
      const float inv = 1.0f / l;
#pragma unroll
      for (int db = 0; db < 2; ++db)
#pragma unroll
        for (int r = 0; r < 16; ++r) o[db][r] *= inv;
      attn_store<2>(lds, mixed, tok - l31, 768 + head * 64, o, wid, lane);
    }
  }
}

struct WDesc { const float* src; bf16_t* dst; const float* gain; int K, Kpad, Nsrc, Npad, mode; };
__device__ __forceinline__ void get_wdesc(const Params& p, int layer, int kind, WDesc& d) {
  unsigned char* wl = p.ws + WS_W + (size_t)layer * SZ_WL;
  d.gain = nullptr; d.mode = 0;
  switch (kind) {
    case 0: d.src = p.in[4] + (size_t)layer * D * GU; d.dst = (bf16_t*)(wl + WO_GU1); d.gain = p.in[3] + layer * D; d.K = D; d.Kpad = D; d.Nsrc = GU; d.Npad = GU; d.mode = 1; break;
    case 1: d.src = p.in[5] + (size_t)layer * FF * D; d.dst = (bf16_t*)(wl + WO_D1); d.K = FF; d.Kpad = FF; d.Nsrc = D; d.Npad = D; break;
    case 2: d.src = p.in[7] + (size_t)layer * D * 2720; d.dst = (bf16_t*)(wl + WO_IN); d.gain = p.in[6] + layer * D; d.K = D; d.Kpad = D; d.Nsrc = 2720; d.Npad = NQ; break;
    case 3: d.src = p.in[9] + (size_t)layer * 256 * 384; d.dst = (bf16_t*)(wl + WO_UPQ); d.gain = p.in[8] + layer * 256; d.K = 256; d.Kpad = 256; d.Nsrc = 384; d.Npad = 512; break;
    case 4: d.src = p.in[11] + (size_t)layer * 128 * 512; d.dst = (bf16_t*)(wl + WO_UPKV); d.gain = p.in[10] + layer * 128; d.K = 128; d.Kpad = 256; d.Nsrc = 512; d.Npad = 512; d.mode = 2; break;
    case 5: d.src = p.in[17] + (size_t)layer * D * D; d.dst = (bf16_t*)(wl + WO_OUT); d.K = D; d.Kpad = D; d.Nsrc = D; d.Npad = D; break;
    case 6: d.src = p.in[19] + (size_t)layer * D * GU; d.dst = (bf16_t*)(wl + WO_GU2); d.gain = p.in[18] + layer * D; d.K = D; d.Kpad = D; d.Nsrc = GU; d.Npad = GU; d.mode = 1; break;
    case 7: d.src = p.in[20] + (size_t)layer * FF * D; d.dst = (bf16_t*)(wl + WO_D2); d.K = FF; d.Kpad = FF; d.Nsrc = D; d.Npad = D; break;
    case 8: d.src = p.in[22] + (size_t)layer * D * D; d.dst = (bf16_t*)(wl + WO_GATE); d.gain = p.in[21] + layer * D; d.K = D; d.Kpad = D; d.Nsrc = D; d.Npad = D; break;
    default: d.src = p.in[23] + (size_t)layer * 256 * D; d.dst = (bf16_t*)(wl + WO_PJ); d.K = 256; d.Kpad = 256; d.Nsrc = D; d.Npad = D; break;
  }
}
__device__ __forceinline__ int wsrc_col(int mode, int n, int Nsrc) {
  if (mode == 1) return ((n >> 7) & 1) * FF + (n >> 8) * 128 + (n & 127);
  if (mode == 2) return n < 256 ? (n >> 6) * 128 + (n & 63) : ((n - 256) >> 6) * 128 + 64 + (n & 63);
  return n < Nsrc ? n : -1;
}

__device__ __forceinline__ void prologue(const Params& p, LAS unsigned char* lds) {
  const int tid = opaque_tid(), nb = gridDim.x, bid = blockIdx.x;
  unsigned char* ws = p.ws;
  if (bid == 0 && tid < 64) ((int*)(ws + WS_CTR))[tid] = 0;
  { float* cosd = (float*)(ws + WS_ROPE); float* sind = cosd + T * 8; float* cosm = sind + T * 8; float* sinm = cosm + T * 16;
    const int* pos = (const int*)p.in[2];
    for (int i = bid * 512 + tid; i < T * 24; i += nb * 512) {
      int tok, j; float invf;
      if (i < T * 8) { tok = i >> 3; j = i & 7; invf = 1.0f / powf(500000.0f, (float)(2 * j) / 16.0f); }
      else { const int k = i - T * 8; tok = k >> 4; j = k & 15; invf = 1.0f / powf(500000.0f, (float)(2 * j) / 32.0f); }
      const float ang = (float)pos[tok] * invf;
      double rev = (double)ang * 0.15915494309189535; rev -= rint(rev);
      const float rr = (float)(rev * 6.283185307179586);
      const float c = __cosf(rr), s = __sinf(rr);
      if (i < T * 8) { cosd[tok * 8 + j] = c; sind[tok * 8 + j] = s; } else { cosm[tok * 16 + j] = c; sinm[tok * 16 + j] = s; }
    } }
  { const f32x4* src = (const f32x4*)p.in[1]; u32x2* dst = (u32x2*)(ws + WS_PB); const size_t n = (size_t)NL * T * 256 / 4;
    const size_t stride = (size_t)nb * 512;
    size_t i = (size_t)bid * 512 + tid;
    for (; i + 3 * stride < n; i += 4 * stride) {
      f32x4 v[4];
#pragma unroll
      for (int u = 0; u < 4; ++u) v[u] = __builtin_nontemporal_load(src + i + u * stride);
#pragma unroll
      for (int u = 0; u < 4; ++u) { u32x2 w; w.x = cvt_pk_bf16(v[u][0], v[u][1]); w.y = cvt_pk_bf16(v[u][2], v[u][3]); dst[i + u * stride] = w; }
    }
    for (; i < n; i += stride) { const f32x4 v = src[i]; u32x2 w; w.x = cvt_pk_bf16(v[0], v[1]); w.y = cvt_pk_bf16(v[2], v[3]); dst[i] = w; } }
  { const int wid = tid >> 6, lane = tid & 63; float* ssq0 = (float*)(ws + WS_SSQ); bf16_t* hb = (bf16_t*)(ws + WS_HB);
    for (int row = bid * 8 + wid; row < T; row += nb * 8) {
      float sq = 0.f;
#pragma unroll
      for (int i = 0; i < 4; ++i) { const size_t off = (size_t)row * D + i * 256 + lane * 4; const f32x4 v = *(const f32x4*)(p.in[0] + off);
        store_bf4(hb + off, v); sq += v[0] * v[0] + v[1] * v[1] + v[2] * v[2] + v[3] * v[3]; }
      sq = wave_sum(sq);
      if (lane < 16) ssq0[(size_t)row * 16 + lane] = lane == 0 ? sq : 0.f;
    } }
  { constexpr int NT_KIND[10] = {1408, 704, 704, 32, 32, 256, 1408, 704, 256, 64};
    constexpr int PER_LAYER = 5568;
    const int wid = tid >> 6, lane = tid & 63;
    for (int t = bid * 8 + wid; t < NL * PER_LAYER; t += nb * 8) {
      const int layer = t / PER_LAYER; int r = t % PER_LAYER, kind = 0;
#pragma unroll
      for (int k = 0; k < 9; ++k) { if (kind == k && r >= NT_KIND[k]) { r -= NT_KIND[k]; kind = k + 1; } }
      WDesc d; get_wdesc(p, layer, kind, d);
      const int nkt = d.Kpad / 64, n0 = (r / nkt) * 64, k0 = (r % nkt) * 64;
      const int sc = wsrc_col(d.mode, n0 + lane, d.Nsrc);
      const bool live = sc >= 0 && k0 < d.K;
      const float* sp = d.src + (size_t)k0 * d.Nsrc + (sc >= 0 ? sc : 0);
      bf16_t* dp = d.dst + (size_t)(n0 + lane) * d.Kpad + k0;
      float v[64];
#pragma unroll
      for (int e = 0; e < 64; ++e) v[e] = live ? __builtin_nontemporal_load(sp + (size_t)e * d.Nsrc) : 0.f;
      if (d.gain && live) {
#pragma unroll
        for (int e = 0; e < 64; ++e) v[e] *= d.gain[k0 + e];
      }
#pragma unroll
      for (int kc = 0; kc < 8; ++kc) {
        u32x4 w; w.x = cvt_pk_bf16(v[kc * 8 + 0], v[kc * 8 + 1]); w.y = cvt_pk_bf16(v[kc * 8 + 2], v[kc * 8 + 3]); w.z = cvt_pk_bf16(v[kc * 8 + 4], v[kc * 8 + 5]); w.w = cvt_pk_bf16(v[kc * 8 + 6], v[kc * 8 + 7]);
        *(u32x4*)(dp + kc * 8) = w;
      }
    }
  }
}

__device__ __forceinline__ void rope_sweep(const Params& p) {
  unsigned char* ws = opq(p.ws); const bf16_t* ckv = (const bf16_t*)(ws + WS_CKV); bf16_t* km = (bf16_t*)(ws + WS_KM);
  const float* cosm = (const float*)(ws + WS_ROPE) + T * 16; const float* sinm = cosm + T * 16;
  for (int tok = blockIdx.x * 512 + opaque_tid(); tok < T; tok += gridDim.x * 512) {
    const bf16_t* src = ckv + (size_t)tok * 256 + 128;
    float x[32];
#pragma unroll
    for (int q = 0; q < 4; ++q) { const u32x4 w = *(const u32x4*)(src + q * 8); const unsigned* wp = (const unsigned*)&w;
#pragma unroll
      for (int j = 0; j < 4; ++j) { x[q * 8 + 2 * j] = bf2f(wp[j] & 0xffffu); x[q * 8 + 2 * j + 1] = __uint_as_float(wp[j] & 0xffff0000u); } }
    unsigned o[16];
#pragma unroll
    for (int j = 0; j < 16; j += 2) {
      const float c0 = cosm[tok * 16 + j], s0 = sinm[tok * 16 + j], c1 = cosm[tok * 16 + j + 1], s1 = sinm[tok * 16 + j + 1];
      o[j / 2] = cvt_pk_bf16(x[j] * c0 - x[j + 16] * s0, x[j + 1] * c1 - x[j + 17] * s1);
      o[8 + j / 2] = cvt_pk_bf16(x[j + 16] * c0 + x[j] * s0, x[j + 17] * c1 + x[j + 1] * s1);
    }
#pragma unroll
    for (int h = 0; h < 4; ++h) { u32x4* dst = (u32x4*)(km + (size_t)tok * 384 + h * 96 + 64);
#pragma unroll
      for (int q = 0; q < 4; ++q) { u32x4 w; w.x = o[q * 4]; w.y = o[q * 4 + 1]; w.z = o[q * 4 + 2]; w.w = o[q * 4 + 3]; dst[q] = w; } }
  }
}

__device__ __forceinline__ void final_norm(const Params& p) {
  const int tid = opaque_tid(), wid = tid >> 6, lane = tid & 63; const float* ssq = (const float*)(p.ws + WS_SSQ); const float* gain = p.in[24];
  for (int row = blockIdx.x * 8 + wid; row < T; row += gridDim.x * 8) {
    const float rs = rsqrtf(sum16(ssq + (size_t)row * 16) * (1.0f / D) + EPS);
#pragma unroll
    for (int i = 0; i < 4; ++i) { const size_t off = (size_t)row * D + i * 256 + lane * 4; f32x4 v = load_bf4((const bf16_t*)(p.ws + WS_HB2) + off); const f32x4 g = *(const f32x4*)(gain + i * 256 + lane * 4);
      v = v * rs * g;
      *(f32x4*)(p.out + off) = v; }
  }
}

constexpr int LDS_BYTES = pg8::STAGE_BYTES + 16;

__global__ void __launch_bounds__(512) mk_forward(Params p) {
  extern __shared__ __attribute__((aligned(16))) unsigned char smem[];
  LAS unsigned char* lds = (LAS unsigned char*)smem;
  cg::grid_group grid = cg::this_grid();
  if (threadIdx.x == 0) { *(LAS u32x4*)(lds + pg8::STAGE_BYTES) = (u32x4){0u, 0u, 0u, 0u}; }
  __syncthreads();
  const XcdBarrier xbar = xcd_barrier_post((unsigned*)(p.ws + WS_BAR), (volatile LAS unsigned*)(lds + pg8::STAGE_BYTES));
  unsigned char* ws = p.ws;
  const int G = gridDim.x;

  prologue(p, lds);
  grid.sync();
  { volatile LAS unsigned* st = (volatile LAS unsigned*)(lds + pg8::STAGE_BYTES);
    if (threadIdx.x == 0) {
      unsigned* bar = (unsigned*)(p.ws + WS_BAR); unsigned nx = 0, idx = 0, per = 0; bool ok = true;
      for (unsigned j = 0; j < 16; ++j) { const unsigned c = xb_ld(&bar[XB_XCNT(j)]); if (c) { if (j < xbar.x) ++idx; ++nx; if (per == 0) per = c; else if (c != per) ok = false; } }
      ok = ok && nx == 8u && per * nx == (unsigned)G && st[2] < per;
      st[3] = ok ? (0x80000000u | (st[2] * nx + idx)) : blockIdx.x;
    }
    __syncthreads(); }
  const unsigned vbw = ((volatile LAS unsigned*)(lds + pg8::STAGE_BYTES))[3];
  const int bid0 = __builtin_amdgcn_readfirstlane((int)(vbw & 0x7fffffffu));
  const bool local_ok = __builtin_amdgcn_readfirstlane((int)(vbw >> 31)) != 0;
#define SEAM_LOCAL() do { if (local_ok) xcd_barrier_local(xbar); else xcd_barrier(xbar); } while (0)

  for (int layer = 0; layer < NL; ++layer) {
    int bid = bid0; asm volatile("" : "+s"(bid));
    pg8::StaticOrder so;
    const size_t HB1 = layer ? WS_HB2 : WS_HB;
    { unsigned char* w = opq(ws); unsigned char* wl = w + WS_W + (size_t)layer * SZ_WL; float* sA = (float*)(w + WS_SSQ); float* sB = sA + (size_t)T * 16;
      so.init(T, GU, G, bid); pg8::gemm_phase<true>(lds, pg8::Gemm{(const bf16_t*)(w + HB1), (const bf16_t*)(wl + WO_GU1), T, GU, D}, so, EpiGU{sA, (bf16_t*)(w + WS_ACT)}); }
    SEAM_LOCAL();
    { unsigned char* w = opq(ws); unsigned char* wl = w + WS_W + (size_t)layer * SZ_WL; float* sA = (float*)(w + WS_SSQ); float* sB = sA + (size_t)T * 16;
      so.init(T, D, G, bid); pg8::gemm_phase<true>(lds, pg8::Gemm{(const bf16_t*)(w + WS_ACT), (const bf16_t*)(wl + WO_D1), T, D, FF}, so, EpiResP{layer ? (const float*)nullptr : opq(p.in[0]), (const bf16_t*)(w + WS_HB2), (bf16_t*)(w + WS_HB), sB, 0.5f}); }
    xcd_barrier(xbar);
    { unsigned char* w = opq(ws); unsigned char* wl = w + WS_W + (size_t)layer * SZ_WL; float* sA = (float*)(w + WS_SSQ); float* sB = sA + (size_t)T * 16;
      so.init(T, NQ, G, bid); pg8::gemm_phase(lds, pg8::Gemm{(const bf16_t*)(w + WS_HB), (const bf16_t*)(wl + WO_IN), T, NQ, D}, so,
        EpiWin{sB, (bf16_t*)(w + WS_QKV), (bf16_t*)(w + WS_CQ), (bf16_t*)(w + WS_CKV), (bf16_t*)(w + WS_VTSB), (bf16_t*)(w + WS_VTDF),
               (float*)(w + WS_SSQQ), (float*)(w + WS_SSQKV), (const float*)(w + WS_ROPE), (const float*)(w + WS_ROPE) + T * 8}); }
    xcd_barrier(xbar);
    { unsigned char* w = opq(ws); unsigned char* wl = w + WS_W + (size_t)layer * SZ_WL;
      const float* cosm = (const float*)(w + WS_ROPE) + T * 16; const float* sinm = cosm + T * 16;
      so.init(T, 512, G, bid < G / 2 ? bid : -1); pg8::gemm_phase(lds, pg8::Gemm{(const bf16_t*)(w + WS_CQ), (const bf16_t*)(wl + WO_UPQ), T, 512, 256}, so,
        EpiUpQ{(float*)(w + WS_SSQQ), (bf16_t*)(w + WS_QM), cosm, sinm});
      so.init(T, 512, G - G / 2, bid >= G / 2 ? bid - G / 2 : -1); pg8::gemm_phase(lds, pg8::Gemm{(const bf16_t*)(w + WS_CKV), (const bf16_t*)(wl + WO_UPKV), T, 512, 256}, so,
        EpiUpKV{(float*)(w + WS_SSQKV), (bf16_t*)(w + WS_KM), (bf16_t*)(w + WS_VTML)});
      rope_sweep(p); }
    { asm volatile("s_waitcnt vmcnt(0)" ::: "memory"); __syncthreads();
      if (threadIdx.x == 0) { __builtin_amdgcn_fence(__ATOMIC_RELEASE, "agent"); asm volatile("s_waitcnt vmcnt(0)" ::: "memory");
        __hip_atomic_fetch_add((unsigned*)(opq(ws) + WS_CTR) + 16 + layer, 1u, __ATOMIC_RELAXED, __HIP_MEMORY_SCOPE_AGENT); } }
    attn_phase(p, layer, lds, (int*)(opq(ws) + WS_CTR) + layer, (unsigned*)(opq(ws) + WS_CTR) + 16 + layer);
    xcd_barrier(xbar);
    { unsigned char* w = opq(ws); unsigned char* wl = w + WS_W + (size_t)layer * SZ_WL; float* sA = (float*)(w + WS_SSQ); float* sB = sA + (size_t)T * 16;
      so.init(T, D, G, bid); pg8::gemm_phase<true>(lds, pg8::Gemm{(const bf16_t*)(w + WS_MIX), (const bf16_t*)(wl + WO_OUT), T, D, D}, so, EpiResP{(const float*)nullptr, (const bf16_t*)(w + WS_HB), (bf16_t*)(w + WS_HB), sA, 1.0f}); }
    SEAM_LOCAL();
    { unsigned char* w = opq(ws); unsigned char* wl = w + WS_W + (size_t)layer * SZ_WL; float* sA = (float*)(w + WS_SSQ); float* sB = sA + (size_t)T * 16;
      so.init(T, GU, G, bid); pg8::gemm_phase<true>(lds, pg8::Gemm{(const bf16_t*)(w + WS_HB), (const bf16_t*)(wl + WO_GU2), T, GU, D}, so, EpiGU{sA, (bf16_t*)(w + WS_ACT)});
      so.init(T, D, G - G / 2, bid >= G / 2 ? bid - G / 2 : -1); pg8::gemm_phase(lds, pg8::Gemm{(const bf16_t*)(w + WS_PB) + (size_t)layer * T * 256, (const bf16_t*)(wl + WO_PJ), T, D, 256}, so, EpiProj{(bf16_t*)(w + WS_MIX)}); }
    SEAM_LOCAL();
    { unsigned char* w = opq(ws); unsigned char* wl = w + WS_W + (size_t)layer * SZ_WL; float* sA = (float*)(w + WS_SSQ); float* sB = sA + (size_t)T * 16;
      so.init(T, D, G, bid); pg8::gemm_phase<true>(lds, pg8::Gemm{(const bf16_t*)(w + WS_ACT), (const bf16_t*)(wl + WO_D2), T, D, FF}, so, EpiResP{(const float*)nullptr, (const bf16_t*)(w + WS_HB), (bf16_t*)(w + WS_HB), sB, 0.5f}); }
    SEAM_LOCAL();
    { unsigned char* w = opq(ws); unsigned char* wl = w + WS_W + (size_t)layer * SZ_WL; float* sA = (float*)(w + WS_SSQ); float* sB = sA + (size_t)T * 16;
      so.init(T, D, G, bid); pg8::gemm_phase<true>(lds, pg8::Gemm{(const bf16_t*)(w + WS_HB), (const bf16_t*)(wl + WO_GATE), T, D, D}, so, EpiPleP{sB, (const bf16_t*)(w + WS_MIX), (const bf16_t*)(w + WS_HB), (bf16_t*)(w + WS_HB2), sA}); }
    if (layer + 1 < NL) SEAM_LOCAL(); else xcd_barrier(xbar);
  }
  final_norm(p);
}

extern "C" void kernel_launch(void* const* d_in, const int* in_sizes, int n_in, void* d_out, int out_size, void* d_ws, size_t ws_size, hipStream_t stream) {
  static int grid = 0;
  if (grid == 0) {
    int dev = 0, cus = 0, per_cu = 0;
    if (n_in != 25 || out_size != T * D || ws_size < WS_END) { fprintf(stderr, "kernel_launch: unexpected shapes (n_in %d out %d ws %zu need %zu)\n", n_in, out_size, ws_size, (size_t)WS_END); grid = -1; return; }
    (void)hipGetDevice(&dev);
    (void)hipDeviceGetAttribute(&cus, hipDeviceAttributeMultiprocessorCount, dev);
    if (hipFuncSetAttribute((const void*)mk_forward, hipFuncAttributeMaxDynamicSharedMemorySize, LDS_BYTES) != hipSuccess) { fprintf(stderr, "kernel_launch: hipFuncSetAttribute failed\n"); grid = -1; return; }
    (void)hipOccupancyMaxActiveBlocksPerMultiprocessor(&per_cu, (const void*)mk_forward, 512, LDS_BYTES);
    (void)hipGetLastError();
    if (per_cu < 1) fprintf(stderr, "kernel_launch: occupancy query says %d blocks per CU\n", per_cu);
    grid = cus;
  }
  if (grid < 0) return;
  Params p{};
  for (int i = 0; i < 25; ++i) p.in[i] = (const float*)d_in[i];
  p.out = (float*)d_out; p.ws = (unsigned char*)d_ws;
  if (hipMemsetAsync((unsigned char*)d_ws + WS_BAR, 0, XCD_BAR_WORDS * 4, stream) != hipSuccess) { fprintf(stderr, "kernel_launch: memset of the barrier words failed\n"); return; }
  void* args[] = {&p};
  hipError_t e = hipLaunchCooperativeKernel((const void*)mk_forward, dim3(grid), dim3(512), args, LDS_BYTES, stream);
  if (e != hipSuccess) fprintf(stderr, "kernel_launch: cooperative launch failed: %s (grid %d)\n", hipGetErrorString(e), grid);
}
```
